# Optimizing an MI355X kernel written in HIP

```python
import jax, jax.numpy as jnp
from jax import lax
import numpy as np

D_MODEL = 2048
BATCH = 1
SEQ = 8192
DEPTH = 4

HGRN_HEADS = 8
HGRN_KEY_DIM = 128
HGRN_VAL_DIM = 128
HGRN_WIDTH = HGRN_HEADS * HGRN_KEY_DIM
HGRN_CHUNK = 64
MIN_FORGET = 1e-30
ATTN_GROUPS = ((128, 1), (512, 4), (2048, 16))
HEADS_PER_GROUP = 4
ATTN_HEAD_DIM = 128
N_ATTN_HEADS = HEADS_PER_GROUP * len(ATTN_GROUPS)
ATTN_WIDTH = N_ATTN_HEADS * ATTN_HEAD_DIM
ATTN_OUT_WIDTH = HEADS_PER_GROUP * ATTN_HEAD_DIM
ATTN_BLOCK = 128
REL_BUCKETS = 32
REL_MAX_DISTANCE = 1024
D_FF = 4 * D_MODEL
NORM_EPS = 1e-6
NEG_INF = -1e30
IN_SPLITS = (HGRN_WIDTH,) * 5 + (ATTN_WIDTH,) * 3 + (D_MODEL,) * 2
N_IN = sum(IN_SPLITS)

kernel_name = "hybrid_hgrn2_dilated_attn_encoder"


def rms_norm(x, w):
    xf = x.astype(jnp.float32)
    y = xf * lax.rsqrt(jnp.mean(xf * xf, axis=-1, keepdims=True) + NORM_EPS)
    return (y * w.astype(jnp.float32)).astype(x.dtype)


def layer_lower_bounds(logits):
    p = jax.nn.softmax(logits.astype(jnp.float32), axis=0)
    return jnp.cumsum(p, axis=0) - p[0:1]


def hgrn2_chunk_scan(q, k, log_f, v):
    B, S, H, K = q.shape
    V = v.shape[-1]
    C = HGRN_CHUNK
    n = S // C

    def to_chunks(a):
        return a.reshape(B, n, C, H, a.shape[-1]).transpose(1, 0, 3, 2, 4)

    causal_in_chunk = jnp.asarray(np.tril(np.ones((C, C), dtype=bool)))[:, :, None]

    def step(state, inp):
        qb, kb, gb, vb = inp
        b = jnp.cumsum(gb, axis=2)
        diff = b[:, :, :, None, :] - b[:, :, None, :, :]
        decay = jnp.where(causal_in_chunk, jnp.exp(jnp.where(causal_in_chunk, diff, 0.0)), 0.0)
        scores = jnp.einsum('bhtk,bhsk,bhtsk->bhts', qb, kb, decay)
        o = (jnp.einsum('bhts,bhsv->bhtv', scores, vb)
             + jnp.einsum('bhtk,bhkv->bhtv', qb * jnp.exp(b), state))
        b_last = b[:, :, -1:, :]
        state = (state * jnp.exp(b_last)[:, :, 0, :, None]
                 + jnp.einsum('bhsk,bhsv->bhkv', kb * jnp.exp(b_last - b), vb))
        return state, o

    state0 = jnp.zeros((B, H, K, V), jnp.float32)
    _, o = lax.scan(step, state0, (to_chunks(q), to_chunks(k), to_chunks(log_f), to_chunks(v)))
    return o.transpose(1, 0, 3, 2, 4).reshape(B, S, H, V)


def hgrn2_branch(q, z_fwd, z_bwd, i, g, lb_fwd, lb_bwd, norm_w):
    B, S, _ = q.shape

    def heads(a, d):
        return a.reshape(B, S, HGRN_HEADS, d).astype(jnp.float32)

    qh = heads(q, HGRN_KEY_DIM)
    vh = heads(i, HGRN_VAL_DIM)

    def gates(z, lb):
        z = heads(z, HGRN_KEY_DIM)
        lb = lb.reshape(HGRN_HEADS, HGRN_KEY_DIM)
        f = lb + (1.0 - lb) * jax.nn.sigmoid(z)
        log_f = jnp.log(jnp.maximum(f, MIN_FORGET))
        key = (1.0 - lb) * jax.nn.sigmoid(-z)
        return log_f, key

    lf_f, k_f = gates(z_fwd, lb_fwd)
    lf_b, k_b = gates(z_bwd, lb_bwd)
    rev = lambda a: jnp.flip(a, axis=1)
    o_f = hgrn2_chunk_scan(qh, k_f, lf_f, vh)
    o_b = rev(hgrn2_chunk_scan(rev(qh), rev(k_b), rev(lf_b), rev(vh)))
    o = o_f + o_b
    o = o * lax.rsqrt(jnp.mean(o * o, axis=-1, keepdims=True) + NORM_EPS)
    o = o.reshape(B, S, HGRN_WIDTH) * norm_w.astype(jnp.float32) * jax.nn.silu(g.astype(jnp.float32))
    return o.astype(q.dtype)


def t5_bucket(rel):
    half = REL_BUCKETS // 2
    ret = (rel > 0).astype(np.int32) * half
    n = np.abs(rel)
    max_exact = half // 2
    large = max_exact + (np.log(np.maximum(n, 1) / max_exact)
                         / np.log(REL_MAX_DISTANCE / max_exact)
                         * (half - max_exact)).astype(np.int32)
    large = np.minimum(large, half - 1)
    return (ret + np.where(n < max_exact, n, large)).astype(np.int32)


def dilated_group_attention(q, k, v, bias_table, n_side, dil):
    B, S, G, Dh = q.shape
    L = S // dil

    def sub(a):
        return a.reshape(B, L, dil, G, Dh).transpose(0, 2, 3, 1, 4)

    qs, ks, vs = sub(q), sub(k), sub(v)
    qb_len = min(ATTN_BLOCK, L)
    nb = -(-L // qb_len)
    lp = nb * qb_len
    kw = qb_len + 2 * n_side
    pad_q = ((0, 0), (0, 0), (0, 0), (0, lp - L), (0, 0))
    pad_k = ((0, 0), (0, 0), (0, 0), (n_side, lp - L + n_side), (0, 0))
    qs = jnp.pad(qs, pad_q).reshape(B, dil, G, nb, qb_len, Dh)
    key_idx = np.arange(nb)[:, None] * qb_len + np.arange(kw)[None, :]
    kb = jnp.take(jnp.pad(ks, pad_k), key_idx, axis=3)
    vb = jnp.take(jnp.pad(vs, pad_k), key_idx, axis=3)
    rel = np.arange(kw)[None, :] - n_side - np.arange(qb_len)[:, None]
    key_pos = key_idx - n_side
    valid = ((np.abs(rel) <= n_side)[None]
             & ((key_pos >= 0) & (key_pos < L))[:, None, :])
    bias = bias_table[t5_bucket(rel * dil)]
    bias = jnp.transpose(bias, (2, 0, 1))[:, None].astype(jnp.float32)
    scale = ATTN_HEAD_DIM ** -0.5
    s = jnp.einsum('brgnqd,brgnkd->brgnqk', qs, kb).astype(jnp.float32) * scale + bias
    s = jnp.where(jnp.asarray(valid), s, NEG_INF)
    lse = jax.nn.logsumexp(s, axis=-1)
    p = jnp.exp(s - lse[..., None])
    o = jnp.einsum('brgnqk,brgnkd->brgnqd', p, vb.astype(jnp.float32))
    o = o.reshape(B, dil, G, lp, Dh)[:, :, :, :L].transpose(0, 3, 1, 2, 4).reshape(B, S, G, Dh)
    lse = lse.reshape(B, dil, G, lp)[:, :, :, :L].transpose(0, 3, 1, 2).reshape(B, S, G)
    return o, lse


def dilated_attention_branch(q, k, v, rel_bias_table):
    B, S, _ = q.shape
    shp = lambda a: a.reshape(B, S, N_ATTN_HEADS, ATTN_HEAD_DIM)
    q, k, v = shp(q), shp(k), shp(v)
    outs, lses = [], []
    for gi, (window, dil) in enumerate(ATTN_GROUPS):
        hs = slice(gi * HEADS_PER_GROUP, (gi + 1) * HEADS_PER_GROUP)
        o, lse = dilated_group_attention(q[:, :, hs], k[:, :, hs], v[:, :, hs],
                                         rel_bias_table[:, hs], window // (2 * dil), dil)
        outs.append(o)
        lses.append(lse)
    alpha = jax.nn.softmax(jnp.stack(lses), axis=0)
    out = jnp.einsum('nbsg,nbsgd->bsgd', alpha, jnp.stack(outs))
    return out.reshape(B, S, ATTN_OUT_WIDTH).astype(q.dtype)


def setup_inputs(seed: int = 0) -> dict:
    key = jax.random.key(seed)
    ks = jax.random.split(key, 16)
    nrm = lambda k, shape, scale: jax.random.normal(k, shape, jnp.float32) * scale
    return {
        "x": nrm(ks[0], (BATCH, SEQ, D_MODEL), 1.0),
        "w_in": nrm(ks[1], (DEPTH, D_MODEL, N_IN), D_MODEL ** -0.5),
        "hgrn_lb_fwd": nrm(ks[2], (DEPTH, HGRN_WIDTH), 0.5),
        "hgrn_lb_bwd": nrm(ks[3], (DEPTH, HGRN_WIDTH), 0.5),
        "hgrn_norm_w": 1.0 + nrm(ks[4], (DEPTH, HGRN_WIDTH), 0.02),
        "rel_bias_table": nrm(ks[5], (REL_BUCKETS, N_ATTN_HEADS), 0.5),
        "w_branch_hgrn": nrm(ks[6], (DEPTH, HGRN_WIDTH, D_MODEL), HGRN_WIDTH ** -0.5),
        "w_branch_attn": nrm(ks[7], (DEPTH, ATTN_OUT_WIDTH, D_MODEL), ATTN_OUT_WIDTH ** -0.5),
        "w_out": nrm(ks[8], (DEPTH, D_MODEL, D_MODEL), D_MODEL ** -0.5),
        "norm_mix_w": 1.0 + nrm(ks[9], (DEPTH, D_MODEL), 0.02),
        "norm_mlp_w": 1.0 + nrm(ks[10], (DEPTH, D_MODEL), 0.02),
        "w_up": nrm(ks[11], (DEPTH, D_MODEL, D_FF), D_MODEL ** -0.5),
        "w_down": nrm(ks[12], (DEPTH, D_FF, D_MODEL), D_FF ** -0.5),
        "final_norm_w": 1.0 + nrm(ks[13], (D_MODEL,), 0.02),
    }


def reference(x, w_in, hgrn_lb_fwd, hgrn_lb_bwd, hgrn_norm_w, rel_bias_table,
              w_branch_hgrn, w_branch_attn, w_out, norm_mix_w, norm_mlp_w,
              w_up, w_down, final_norm_w):
    lb_fwd_all = layer_lower_bounds(hgrn_lb_fwd)
    lb_bwd_all = layer_lower_bounds(hgrn_lb_bwd)
    split_points = list(np.cumsum(IN_SPLITS)[:-1])
    for l in range(DEPTH):
        h = rms_norm(x, norm_mix_w[l])
        proj = jnp.einsum('bsd,dn->bsn', h, w_in[l])
        (hq, hzf, hzb, hi, hg, aq, ak, av, gate_a, gate_b) = jnp.split(proj, split_points, axis=-1)
        o_hgrn = hgrn2_branch(hq, hzf, hzb, hi, hg, lb_fwd_all[l], lb_bwd_all[l], hgrn_norm_w[l])
        o_attn = dilated_attention_branch(aq, ak, av, rel_bias_table)
        merged = (jax.nn.sigmoid(gate_a) * jnp.einsum('bsc,cd->bsd', o_hgrn, w_branch_hgrn[l])
                  + jax.nn.sigmoid(gate_b) * jnp.einsum('bsc,cd->bsd', o_attn, w_branch_attn[l]))
        x = x + jnp.einsum('bsd,de->bse', merged, w_out[l])
        h2 = rms_norm(x, norm_mlp_w[l])
        u = jnp.square(jax.nn.relu(jnp.einsum('bsd,df->bsf', h2, w_up[l])))
        x = x + jnp.einsum('bsf,fd->bsd', u, w_down[l])
    return rms_norm(x, final_norm_w)
```

```cpp
#include <hip/hip_runtime.h>
#include <cstdio>
#include <cstdint>
#include <cstring>
#include <cmath>
constexpr int NWAVES = 8;
constexpr int SEQ = 8192, DM = 2048, DEPTH = 4, HW = 1024, NHH = 8, HKD = 128, AW = 1536, AOW = 512, DFF = 8192, NIN = 13824, OAW = HW + AOW;
constexpr int M = SEQ;
constexpr size_t MiB = 1u << 20;
constexpr size_t WS_CTL = 0, CTL_ZERO_BYTES = 32768;
constexpr size_t WS_LB = 1 * MiB;
constexpr size_t WS_BIAS = WS_LB + 65536;
constexpr size_t WS_W = 2 * MiB;
constexpr size_t WL_W1 = 0, WL_WU = 54 * MiB, WL_WD = 86 * MiB, WL_WO = 118 * MiB, WL_WA = 126 * MiB, WL_WB = 130 * MiB, WL_STRIDE = 132 * MiB;
constexpr size_t WS_XB = WS_W + 4 * WL_STRIDE;
constexpr size_t WS_QH = WS_XB + 32 * MiB;
constexpr size_t WS_KF = WS_QH + 16 * MiB, WS_KB = WS_KF + 16 * MiB, WS_VH = WS_KB + 16 * MiB, WS_GS = WS_VH + 16 * MiB;
constexpr size_t WS_LFF = WS_GS + 16 * MiB, WS_LFB = WS_LFF + 32 * MiB;
constexpr size_t WS_AQ = WS_LFB + 32 * MiB, WS_AK = WS_AQ + 24 * MiB, WS_AV = WS_AK + 24 * MiB;
constexpr size_t WS_GA = WS_AV + 24 * MiB, WS_GB = WS_GA + 32 * MiB;
constexpr size_t WS_OA = WS_GB + 32 * MiB;
constexpr size_t WS_MG = WS_OA + 24 * MiB;
constexpr size_t WS_UU = WS_MG + 32 * MiB;
constexpr size_t WS_SSP = WS_UU + 128 * MiB;
constexpr size_t WS_SU = WS_SSP + 9 * MiB;
constexpr size_t WS_DD = WS_SU + 64 * MiB;
constexpr size_t WS_OP = WS_DD + 1 * MiB;
constexpr size_t WS_LSE = WS_OP + 24 * MiB;
constexpr size_t WS_END = WS_LSE + 1 * MiB;
constexpr int CW_TMO = 0, CW_CODE = 1, CW_BAR = 4096;

namespace pg8 {
#define PG8_LAS __attribute__((address_space(3)))
typedef unsigned short bf16_t;
typedef short bf16x8 __attribute__((ext_vector_type(8)));
typedef float f32x4 __attribute__((ext_vector_type(4)));
typedef unsigned u32x4 __attribute__((ext_vector_type(4)));
constexpr int BM = 256, BK = 64, HALF = 128, HTB = HALF * BK * 2  , STAGE_BYTES = 8 * HTB, NXCD = 8, WGM = 4;

__host__ __device__ __forceinline__ int lds_byte(int r, int c) { const int st = (r >> 4) * 2 + (c >> 5), rr = r & 15, cc = c & 31, ob = rr * 64 + cc * 2; return st * 1024 + (ob ^ (((ob >> 9) & 1) << 5)); }
__host__ __device__ __forceinline__ void stage_rc(int b, int& R, int& C) { const int st = b / 1024, sb = b % 1024, swz = sb ^ (((sb >> 9) & 1) << 5); R = (st >> 1) * 16 + swz / 64; C = (st & 1) * 32 + (swz % 64) / 2; }
__host__ __device__ __forceinline__ int perm32(int rho) { const int n = rho >> 4, i = rho & 15; return 8 * (i >> 2) + 4 * n + (i & 3); }

struct Unit { int pm, pn; };
struct Gemm { const bf16_t* A; const bf16_t* Bt; int M, N, K, lda, ldb; };

struct StaticOrder {
    int nM, nN, nwg, G, c, rot;
    __host__ __device__ void init(int M, int N, int G_, int c_, int rot_ = 0) { nM = M / BM; nN = N / BM; nwg = nM * nN; G = G_; c = c_; rot = rot_; }
    __host__ __device__ bool next(int i, Unit& u) const {
        const long L = (long)i * G + c; if (L >= nwg) return false;
        int wgid = (int)L; { const int q = nwg / NXCD, r = nwg % NXCD, xcd = wgid % NXCD, off = wgid / NXCD; wgid = (xcd < r ? xcd * (q + 1) : r * (q + 1) + (xcd - r) * q) + off; }
        const int nig = WGM * nN, gid = wgid / nig, fm = gid * WGM, gsz = (nM - fm) < WGM ? (nM - fm) : WGM;
        u.pm = fm + ((wgid % nig) % gsz); u.pn = (wgid % nig) / gsz + rot; if (u.pn >= nN) u.pn -= nN; return true;
    }
    __device__ __forceinline__ void a_ready(const Unit&) const {}
    __device__ __forceinline__ void done(const Unit&) const {}
};


typedef float f32x2_t __attribute__((ext_vector_type(2))); typedef __bf16 bf16x2_t __attribute__((ext_vector_type(2)));
__device__ __forceinline__ unsigned cvt_pk_bf16(float lo, float hi) { f32x2_t v = {lo, hi}; bf16x2_t b = __builtin_convertvector(v, bf16x2_t); return __builtin_bit_cast(unsigned, b); }
__device__ __forceinline__ float bf_lo(unsigned w) { return __uint_as_float(w << 16); }
__device__ __forceinline__ float bf_hi(unsigned w) { return __uint_as_float(w & 0xffff0000u); }
__device__ __forceinline__ u32x4 pack8(const float (&v)[8]) { u32x4 w; w.x = cvt_pk_bf16(v[0], v[1]); w.y = cvt_pk_bf16(v[2], v[3]); w.z = cvt_pk_bf16(v[4], v[5]); w.w = cvt_pk_bf16(v[6], v[7]); return w; }
__device__ __forceinline__ void unpack8(u32x4 w, float (&v)[8]) { v[0] = bf_lo(w.x); v[1] = bf_hi(w.x); v[2] = bf_lo(w.y); v[3] = bf_hi(w.y); v[4] = bf_lo(w.z); v[5] = bf_hi(w.z); v[6] = bf_lo(w.w); v[7] = bf_hi(w.w); }
constexpr float ATTN_QSCALE = 0.08838834764831845f * 1.4426950408889634f;
constexpr float RMS_EPS = 1e-6f;
constexpr int RS_REL = 154048;
__device__ __forceinline__ float row_ss_part(const float* P, int row, int fq) {
    const f32x4 a = *(const f32x4*)(P + (size_t)row * 32 + 8 * fq), b = *(const f32x4*)(P + (size_t)row * 32 + 8 * fq + 4);
    return ((a[0] + a[1]) + (a[2] + a[3])) + ((b[0] + b[1]) + (b[2] + b[3]));
}

__device__ __forceinline__ void row_rstd(PG8_LAS float* rsl, const float* rowss, int pm, int wr, int wc, int fr, int fq, float (&rsv)[2][4]) {
    const int wv = wr * 4 + wc; PG8_LAS float* rs = rsl + wv * 128; PG8_LAS int* tg = (PG8_LAS int*)(rsl + 1024) + wv;
    if (*tg != pm) {
#pragma unroll
        for (int ai = 0; ai < 2; ++ai) {
            float p[4];
#pragma unroll
            for (int m = 0; m < 4; ++m) p[m] = row_ss_part(rowss, pm * BM + ai * HALF + wr * 64 + m * 16 + fr, fq);
#pragma unroll
            for (int m = 0; m < 4; ++m) { float t = p[m]; t += __shfl_xor(t, 16); t += __shfl_xor(t, 32); if (fq == 0) rs[ai * 64 + m * 16 + fr] = 1.0f / sqrtf(t * (1.0f / 2048.0f) + RMS_EPS); }
            asm volatile("" ::: "memory");
        }
        if (fq == 0 && fr == 0) *tg = pm;
    }
#pragma unroll
    for (int ai = 0; ai < 2; ++ai)
#pragma unroll
        for (int m = 0; m < 4; ++m) rsv[ai][m] = rs[ai * 64 + m * 16 + fr];
}

struct EpiG1 {
    static constexpr bool PERM = true, AFTER_DRAIN = false, NORM = true;
    unsigned char* ws; const float* rowss; const float* lb;
    __device__ __forceinline__ void operator()(const f32x4 (&acc)[2][2][4][2], const Unit& u, int wr, int wc, int fr, int fq, PG8_LAS unsigned char* lds) const {
        const int pn = u.pn; int kind, ld, c0; size_t dsto, dstfo = 0; int lbo = 0;
        if (pn < 4)       { kind = 0; dsto = WS_QH; ld = 1024; c0 = pn * 256; }
        else if (pn < 8)  { kind = 1; dsto = WS_KF; dstfo = WS_LFF; ld = 1024; c0 = (pn - 4) * 256; }
        else if (pn < 12) { kind = 1; dsto = WS_KB; dstfo = WS_LFB; ld = 1024; c0 = (pn - 8) * 256; lbo = 1024; }
        else if (pn < 16) { kind = 0; dsto = WS_VH; ld = 1024; c0 = (pn - 12) * 256; }
        else if (pn < 20) { kind = 2; dsto = WS_GS; ld = 1024; c0 = (pn - 16) * 256; }
        else if (pn < 26) { kind = 3; dsto = WS_AQ; ld = 1536; c0 = (pn - 20) * 256; }
        else if (pn < 32) { kind = 0; dsto = WS_AK; ld = 1536; c0 = (pn - 26) * 256; }
        else if (pn < 38) { kind = 0; dsto = WS_AV; ld = 1536; c0 = (pn - 32) * 256; }
        else              { kind = 4; dsto = WS_GA; ld = 2048; c0 = (pn - 38) * 128; }
        const int col = c0 + wc * 32 + 8 * fq;
        bf16_t* dst = (bf16_t*)(ws + dsto); bf16_t* dstf = (bf16_t*)(ws + dstfo);
        float rsv[2][4]; row_rstd((PG8_LAS float*)(lds + RS_REL), rowss, u.pm, wr, wc, fr, fq, rsv);
        if (kind == 4) {
            bf16_t* ga = (bf16_t*)(ws + WS_GA); bf16_t* gb = (bf16_t*)(ws + WS_GB);
#pragma unroll
            for (int ai = 0; ai < 2; ++ai)
#pragma unroll
                for (int m = 0; m < 4; ++m) {
                    const int row = u.pm * BM + ai * HALF + wr * 64 + m * 16 + fr; const float rs = rsv[ai][m];
                    float ra[8], sb[8];
                    const float rsn = -1.4426950408889634f * rs;
#pragma unroll
                    for (int i = 0; i < 8; ++i) { const float ta = 1.0f + __builtin_amdgcn_exp2f(acc[ai][0][m][i >> 2][i & 3] * rsn), tb = 1.0f + fminf(__builtin_amdgcn_exp2f(acc[ai][1][m][i >> 2][i & 3] * rsn), 1e20f);
                        sb[i] = __builtin_amdgcn_rcpf(tb); ra[i] = tb * __builtin_amdgcn_rcpf(ta); }
                    const size_t off = (size_t)row * 2048 + col;
                    *(u32x4*)(ga + off) = pack8(ra); *(u32x4*)(gb + off) = pack8(sb);
                }
            return;
        }
        if (kind == 0) body<0>(acc, u, wr, fr, rsv, dst, dstf, ld, col, lbo); else if (kind == 1) body<1>(acc, u, wr, fr, rsv, dst, dstf, ld, col, lbo);
        else if (kind == 2) body<2>(acc, u, wr, fr, rsv, dst, dstf, ld, col, lbo); else body<3>(acc, u, wr, fr, rsv, dst, dstf, ld, col, lbo);
    }
    template <int KIND>
    __device__ __forceinline__ void body(const f32x4 (&acc)[2][2][4][2], const Unit& u, int wr, int fr, const float (&rsv)[2][4], bf16_t* dst, bf16_t* dstf, int ld, int col, int lbo) const {
#pragma unroll
        for (int bj = 0; bj < 2; ++bj) {
            float lbv[8];
#pragma unroll
            for (int i = 0; i < 8; ++i) lbv[i] = (KIND == 1) ? lb[lbo + col + bj * HALF + i] : 0.f;
#pragma unroll
            for (int ai = 0; ai < 2; ++ai)
#pragma unroll
                for (int m = 0; m < 4; ++m) {
                    const int row = u.pm * BM + ai * HALF + wr * 64 + m * 16 + fr;
                    const float rs = (KIND == 3) ? rsv[ai][m] * ATTN_QSCALE : rsv[ai][m];
                    float v[8];
#pragma unroll
                    for (int i = 0; i < 4; ++i) { v[i] = acc[ai][bj][m][0][i] * rs; v[4 + i] = acc[ai][bj][m][1][i] * rs; }
                    const size_t off = (size_t)row * ld + col + bj * HALF;
                    if constexpr (KIND == 1) {
                        float lf[8];
#pragma unroll
                        for (int i = 0; i < 8; ++i) { const float sp = __builtin_amdgcn_rcpf(1.0f + __builtin_amdgcn_exp2f(v[i] * -1.4426950408889634f)); const float l = lbv[i], f = l + (1.0f - l) * sp;
                            lf[i] = __builtin_amdgcn_logf(fmaxf(f, 1e-30f)); }
                        *(u32x4*)(dstf + off) = pack8(lf);
                    } else {
                        if constexpr (KIND == 2) {
#pragma unroll
                            for (int i = 0; i < 8; ++i) v[i] = v[i] * __builtin_amdgcn_rcpf(1.0f + __builtin_amdgcn_exp2f(v[i] * -1.4426950408889634f));
                        }
                        *(u32x4*)(dst + off) = pack8(v);
                    }
                }
        }
    }
};
struct EpiUp {
    static constexpr bool PERM = true, AFTER_DRAIN = false, NORM = true;
    const float* rowss; bf16_t* O; int ldc;
    __device__ __forceinline__ void operator()(const f32x4 (&acc)[2][2][4][2], const Unit& u, int wr, int wc, int fr, int fq, PG8_LAS unsigned char* lds) const {
        const int col = u.pn * BM + wc * 32 + 8 * fq;
        float rsv[2][4]; row_rstd((PG8_LAS float*)(lds + RS_REL), rowss, u.pm, wr, wc, fr, fq, rsv);
#pragma unroll
        for (int ai = 0; ai < 2; ++ai)
#pragma unroll
            for (int m = 0; m < 4; ++m) {
                const int row = u.pm * BM + ai * HALF + wr * 64 + m * 16 + fr;
                const float rs = rsv[ai][m];
#pragma unroll
                for (int bj = 0; bj < 2; ++bj) {
                    float v[8];
#pragma unroll
                    for (int i = 0; i < 4; ++i) { v[i] = fmaxf(acc[ai][bj][m][0][i], 0.f) * rs; v[4 + i] = fmaxf(acc[ai][bj][m][1][i], 0.f) * rs; }
#pragma unroll
                    for (int i = 0; i < 8; ++i) v[i] *= v[i];
                    *(u32x4*)(O + (size_t)row * ldc + col + bj * HALF) = pack8(v);
                }
            }
    }
};
struct EpiRes {
    static constexpr bool PERM = true, AFTER_DRAIN = false, NORM = false;
    bf16_t* xb; float* ss_next; int ldc;
    __device__ __forceinline__ void operator()(const f32x4 (&acc)[2][2][4][2], const Unit& u, int wr, int wc, int fr, int fq, PG8_LAS unsigned char* lds) const {
        const int col = u.pn * BM + wc * 32 + 8 * fq;
#pragma unroll
        for (int ai = 0; ai < 2; ++ai)
#pragma unroll
            for (int m = 0; m < 4; ++m) {
                const int row = u.pm * BM + ai * HALF + wr * 64 + m * 16 + fr;
                float ss = 0.f;
#pragma unroll
                for (int bj = 0; bj < 2; ++bj) {
                    const size_t off = (size_t)row * ldc + col + bj * HALF;
                    float b[8]; unpack8(*(const u32x4*)(xb + off), b);
                    float v[8];
#pragma unroll
                    for (int i = 0; i < 4; ++i) { v[i] = b[i] + acc[ai][bj][m][0][i]; v[4 + i] = b[4 + i] + acc[ai][bj][m][1][i]; }
                    const u32x4 w = pack8(v); *(u32x4*)(xb + off) = w;
                    float r[8]; unpack8(w, r);
#pragma unroll
                    for (int i = 0; i < 8; ++i) ss += r[i] * r[i];
                }
                ss += __shfl_xor(ss, 16); ss += __shfl_xor(ss, 32);
                if (fq == 0) ss_next[(size_t)row * 32 + u.pn * 4 + wc] = ss;
            }
    }
};
struct EpiGAB {
    static constexpr bool PERM = true, AFTER_DRAIN = false, NORM = false;
    unsigned char* ws; static constexpr int ldc = 2048;
    __device__ __forceinline__ void mid(f32x4 (&acc)[2][2][4][2], const Unit& u, int wr, int wc, int fr, int fq) const {
        const bf16_t* GA = (const bf16_t*)(ws + WS_GA);
        int col = u.pn * BM + wc * 32 + 8 * fq; asm volatile("" : "+v"(col));
#pragma unroll
        for (int ai = 0; ai < 2; ++ai)
#pragma unroll
            for (int m = 0; m < 4; ++m) {
                const int row = u.pm * BM + ai * HALF + wr * 64 + m * 16 + fr;
#pragma unroll
                for (int bj = 0; bj < 2; ++bj) {
                    const size_t off = (size_t)row * ldc + col + bj * HALF;
                    const u32x4 a = *(const u32x4*)(GA + off);
                    acc[ai][bj][m][0][0] *= bf_lo(a.x); acc[ai][bj][m][0][1] *= bf_hi(a.x); acc[ai][bj][m][0][2] *= bf_lo(a.y); acc[ai][bj][m][0][3] *= bf_hi(a.y);
                    acc[ai][bj][m][1][0] *= bf_lo(a.z); acc[ai][bj][m][1][1] *= bf_hi(a.z); acc[ai][bj][m][1][2] *= bf_lo(a.w); acc[ai][bj][m][1][3] *= bf_hi(a.w);
                }
                asm volatile("" ::: "memory");
            }
    }
    __device__ __forceinline__ void operator()(const f32x4 (&acc)[2][2][4][2], const Unit& u, int wr, int wc, int fr, int fq, PG8_LAS unsigned char* lds) const {
        const bf16_t* GB = (const bf16_t*)(ws + WS_GB); bf16_t* MG = (bf16_t*)(ws + WS_MG);
        const int col = u.pn * BM + wc * 32 + 8 * fq;
#pragma unroll
        for (int ai = 0; ai < 2; ++ai)
#pragma unroll
            for (int m = 0; m < 4; ++m) {
                const int row = u.pm * BM + ai * HALF + wr * 64 + m * 16 + fr;
#pragma unroll
                for (int bj = 0; bj < 2; ++bj) {
                    const size_t off = (size_t)row * ldc + col + bj * HALF;
                    float gb[8]; unpack8(*(const u32x4*)(GB + off), gb);
                    float v[8];
#pragma unroll
                    for (int i = 0; i < 4; ++i) { v[i] = gb[i] * acc[ai][bj][m][0][i]; v[4 + i] = gb[4 + i] * acc[ai][bj][m][1][i]; }
                    *(u32x4*)(MG + off) = pack8(v);
                }
            }
    }
};

template <class Epi, class Sched, bool ALIGN_EPI = false, bool SP2 = false, int MIDT = -1>
__device__ __forceinline__ void gemm_phase(PG8_LAS unsigned char* lds, const Gemm g, const Sched& S, const Epi& E, int wave_) {
    int tid_; { int l_; asm volatile("v_mbcnt_lo_u32_b32 %0, -1, 0\n\tv_mbcnt_hi_u32_b32 %0, -1, %0" : "=v"(l_)); tid_ = wave_ * 64 + l_; }
    const int tid = tid_, wid = __builtin_amdgcn_readfirstlane(tid >> 6), lane = tid & 63, wr = wid >> 2, wc = wid & 3, fr = lane & 15, fq = lane >> 4;
    const int K = g.K, nt = K / BK;
    unsigned voffA[2], voffB[2];
#pragma unroll
    for (int i = 0; i < 2; ++i) { int R, C; stage_rc(tid * 16 + i * 8192, R, C); const int Rb = Epi::PERM ? ((R & ~31) + perm32(R & 31)) : R;
        voffA[i] = (unsigned)(R * g.lda + C) * 2u; voffB[i] = (unsigned)(Rb * g.ldb + C) * 2u; }
    const size_t kstep = (size_t)(BK * 2);
    const size_t hstepA = (size_t)HALF * g.lda * 2, hstepB = (size_t)HALF * g.ldb * 2;
    const size_t tstepA = 2 * hstepA, tstepB = 2 * hstepB;
    if constexpr (Epi::NORM) { if (lane == 0) ((PG8_LAS int*)(lds + RS_REL + 4096))[wid] = -1; }
    const unsigned ldsw = (unsigned)wid * 1024u;
    const int aoff = lds_byte(wr * 64 + fr, fq * 8), boff = lds_byte(wc * 32 + fr, fq * 8);
#define PG8_SA(b, h) (((b) * 2 + (h)) * HTB)
#define PG8_SB(b, h) ((4 + (b) * 2 + (h)) * HTB)
#define PG8_STAGE(bufoff, gbase, voff) do { _Pragma("unroll") for (int _i = 0; _i < 2; ++_i) \
        __builtin_amdgcn_global_load_lds((const unsigned*)((const char*)(gbase) + (voff)[_i]), (PG8_LAS unsigned*)(lds + (bufoff) + ldsw + _i * 8192), 16, 0, 0); } while (0)
#define PG8_LDA(dst, b, h) do { _Pragma("unroll") for (int m = 0; m < 4; ++m) _Pragma("unroll") for (int k = 0; k < 2; ++k) dst[m][k] = *(const PG8_LAS bf16x8*)(lds + PG8_SA(b, h) + aoff + m * 2048 + k * 1024); } while (0)
#define PG8_LDB(dst, b, h) do { _Pragma("unroll") for (int n = 0; n < 2; ++n) _Pragma("unroll") for (int k = 0; k < 2; ++k) dst[n][k] = *(const PG8_LAS bf16x8*)(lds + PG8_SB(b, h) + boff + n * 2048 + k * 1024); } while (0)
#define PG8_MMA(ai, bj, At, Bt) do { __builtin_amdgcn_s_setprio(1); _Pragma("unroll") for (int m = 0; m < 4; ++m) _Pragma("unroll") for (int n = 0; n < 2; ++n) _Pragma("unroll") for (int k = 0; k < 2; ++k) \
        acc[ai][bj][m][n] = __builtin_amdgcn_mfma_f32_16x16x32_bf16(Bt[n][k], At[m][k], acc[ai][bj][m][n], 0, 0, 0); __builtin_amdgcn_s_setprio(0); } while (0)
#define PG8_WAIT_V(n) asm volatile("s_waitcnt vmcnt(" #n ")" ::: "memory")
#define PG8_WAIT_L(n) asm volatile("s_waitcnt lgkmcnt(" #n ")" ::: "memory")
#define PG8_BAR __builtin_amdgcn_s_barrier()
#define PG8_SCHED __builtin_amdgcn_sched_barrier(0)
    Unit cur, nxt; int ui = 0;
    if (!S.next(0, cur)) return;
    f32x4 acc[2][2][4][2];
#pragma unroll
    for (int a = 0; a < 2; ++a)
#pragma unroll
        for (int b = 0; b < 2; ++b)
#pragma unroll
            for (int m = 0; m < 4; ++m)
#pragma unroll
                for (int n = 0; n < 2; ++n) acc[a][b][m][n] = (f32x4){0.f, 0.f, 0.f, 0.f};
    bf16x8 At[4][2], B0[2][2], B1[2][2];
    const char* cA = (const char*)g.A + (size_t)cur.pm * tstepA; const char* cB = (const char*)g.Bt + (size_t)cur.pn * tstepB;
    S.a_ready(cur);
    if constexpr (SP2) {
        PG8_STAGE(PG8_SB(0, 0), cB, voffB); PG8_STAGE(PG8_SB(0, 1), cB + hstepB, voffB); PG8_STAGE(PG8_SA(0, 0), cA, voffA); PG8_STAGE(PG8_SA(0, 1), cA + hstepA, voffA);
        if (wr == 1) PG8_BAR;
        PG8_WAIT_V(2); PG8_BAR;
        PG8_STAGE(PG8_SB(1, 0), cB + kstep, voffB); PG8_STAGE(PG8_SA(1, 0), cA + kstep, voffA); PG8_STAGE(PG8_SB(1, 1), cB + hstepB + kstep, voffB);
        PG8_WAIT_V(6); PG8_BAR;
    } else {
        PG8_STAGE(PG8_SB(0, 0), cB, voffB); PG8_STAGE(PG8_SA(0, 0), cA, voffA); PG8_STAGE(PG8_SB(0, 1), cB + hstepB, voffB); PG8_STAGE(PG8_SA(0, 1), cA + hstepA, voffA);
        if (wr == 1) PG8_BAR;
        PG8_WAIT_V(4); PG8_BAR;
        PG8_STAGE(PG8_SB(1, 0), cB + kstep, voffB); PG8_STAGE(PG8_SA(1, 0), cA + kstep, voffA); PG8_STAGE(PG8_SB(1, 1), cB + hstepB + kstep, voffB);
        PG8_WAIT_V(6); PG8_BAR;
    }
    for (;;) {
        const bool has_next = S.next(ui + 1, nxt);
        const char* nA = has_next ? (const char*)g.A + (size_t)nxt.pm * tstepA : cA; const char* nB = has_next ? (const char*)g.Bt + (size_t)nxt.pn * tstepB : cB;
        for (int t = 0; t < nt; t += 2) {
            const bool last = (t == nt - 2);
            if constexpr (MIDT >= 0) { if (t == MIDT) E.mid(acc, cur, wr, wc, fr, fq); }
            const char* a1 = cA + (size_t)(t + 1) * kstep;
            const char* a2 = last ? nA : cA + (size_t)(t + 2) * kstep; const char* b2 = last ? nB : cB + (size_t)(t + 2) * kstep;
            const char* a3 = a2 + kstep; const char* b3 = b2 + kstep;
            if (last && has_next) S.a_ready(nxt);
            if constexpr (SP2) {
            PG8_LDB(B0, 0, 0); PG8_LDB(B1, 0, 1); PG8_SCHED; PG8_LDA(At, 0, 0); PG8_STAGE(PG8_SA(1, 1), a1 + hstepA, voffA);
            PG8_WAIT_V(8); PG8_WAIT_L(0); PG8_BAR; PG8_MMA(0, 0, At, B0); PG8_MMA(0, 1, At, B1); PG8_BAR; PG8_SCHED;
            PG8_LDA(At, 0, 1); PG8_STAGE(PG8_SB(0, 0), b2, voffB); PG8_STAGE(PG8_SB(0, 1), b2 + hstepB, voffB); PG8_STAGE(PG8_SA(0, 0), a2, voffA);
            PG8_WAIT_V(8); PG8_WAIT_L(0); PG8_BAR; PG8_MMA(1, 0, At, B0); PG8_MMA(1, 1, At, B1); PG8_BAR; PG8_SCHED;
            PG8_LDB(B0, 1, 0); PG8_LDB(B1, 1, 1); PG8_SCHED; PG8_LDA(At, 1, 0); PG8_STAGE(PG8_SA(0, 1), a2 + hstepA, voffA);
            PG8_WAIT_V(8); PG8_WAIT_L(0); PG8_BAR; PG8_MMA(0, 0, At, B0); PG8_MMA(0, 1, At, B1); PG8_BAR; PG8_SCHED;
            PG8_LDA(At, 1, 1); PG8_STAGE(PG8_SB(1, 0), b3, voffB); PG8_STAGE(PG8_SB(1, 1), b3 + hstepB, voffB); PG8_STAGE(PG8_SA(1, 0), a3, voffA);
            PG8_WAIT_V(8); PG8_WAIT_L(0); PG8_BAR; PG8_MMA(1, 0, At, B0); PG8_MMA(1, 1, At, B1); PG8_BAR; PG8_SCHED;
            } else {
            PG8_LDB(B0, 0, 0); PG8_SCHED; PG8_LDA(At, 0, 0); PG8_STAGE(PG8_SA(1, 1), a1 + hstepA, voffA);
            PG8_WAIT_L(8); PG8_BAR; PG8_WAIT_L(0); PG8_MMA(0, 0, At, B0); PG8_BAR; PG8_SCHED;
            PG8_LDB(B1, 0, 1); PG8_STAGE(PG8_SB(0, 0), b2, voffB);
            PG8_BAR; PG8_WAIT_L(0); PG8_MMA(0, 1, At, B1); PG8_BAR;
            PG8_LDA(At, 0, 1); PG8_STAGE(PG8_SA(0, 0), a2, voffA);
            PG8_BAR; PG8_WAIT_L(0); PG8_MMA(1, 0, At, B0); PG8_BAR; PG8_SCHED;
            PG8_STAGE(PG8_SB(0, 1), b2 + hstepB, voffB);
            PG8_WAIT_V(6); PG8_BAR; PG8_MMA(1, 1, At, B1); PG8_BAR;
            PG8_LDB(B0, 1, 0); PG8_SCHED; PG8_LDA(At, 1, 0); PG8_STAGE(PG8_SA(0, 1), a2 + hstepA, voffA);
            PG8_WAIT_L(8); PG8_BAR; PG8_WAIT_L(0); PG8_MMA(0, 0, At, B0); PG8_BAR; PG8_SCHED;
            PG8_LDB(B1, 1, 1); PG8_STAGE(PG8_SB(1, 0), b3, voffB);
            PG8_BAR; PG8_WAIT_L(0); PG8_MMA(0, 1, At, B1); PG8_BAR;
            PG8_LDA(At, 1, 1); PG8_STAGE(PG8_SA(1, 0), a3, voffA);
            PG8_BAR; PG8_WAIT_L(0); PG8_MMA(1, 0, At, B0); PG8_BAR; PG8_SCHED;
            PG8_STAGE(PG8_SB(1, 1), b3 + hstepB, voffB);
            PG8_WAIT_V(6); PG8_BAR; PG8_MMA(1, 1, At, B1); PG8_BAR;
            }
        }
        if constexpr (ALIGN_EPI) { if (wr == 0) PG8_BAR; }
        if constexpr (!Epi::AFTER_DRAIN) { E(acc, cur, wr, wc, fr, fq, lds); S.done(cur); }
        if (!has_next) break;
#pragma unroll
        for (int a = 0; a < 2; ++a)
#pragma unroll
            for (int b = 0; b < 2; ++b)
#pragma unroll
                for (int m = 0; m < 4; ++m)
#pragma unroll
                    for (int n = 0; n < 2; ++n) acc[a][b][m][n] = (f32x4){0.f, 0.f, 0.f, 0.f};
        cur = nxt; cA = nA; cB = nB; ++ui;
        if constexpr (ALIGN_EPI) { if (wr == 1) PG8_BAR; }
    }
    PG8_WAIT_V(0);
    if constexpr (!ALIGN_EPI) { if (wr == 0) PG8_BAR; }
    PG8_BAR;
    if constexpr (Epi::AFTER_DRAIN) { E.fused(acc, cur, wr, wc, fr, fq, lds, wid, lane); S.done(cur); }
#undef PG8_SA
#undef PG8_SB
#undef PG8_STAGE
#undef PG8_LDA
#undef PG8_LDB
#undef PG8_MMA
#undef PG8_WAIT_V
#undef PG8_WAIT_L
#undef PG8_BAR
#undef PG8_SCHED
}
}

constexpr int RING_OFF = 0, RING_BYTES = 131072;
constexpr int MIX_LDS_BYTES = 153600;
constexpr int LDSCTL_OFF = MIX_LDS_BYTES, MISC_OFF = LDSCTL_OFF + 320;
constexpr int RS_OFF = MISC_OFF + 128;
constexpr int LDS_BYTES = 159744;
static_assert(RS_OFF + 4096 + 32 <= LDS_BYTES && RS_OFF == RING_OFF + pg8::RS_REL, "LDS map");

#define GAS __attribute__((address_space(1)))
#define LAS __attribute__((address_space(3)))
typedef unsigned short bf16;
typedef unsigned v4u __attribute__((ext_vector_type(4)));
typedef float f32x4 __attribute__((ext_vector_type(4)));
typedef short bf16x8 __attribute__((ext_vector_type(8)));
typedef GAS unsigned gu32;
#define RLX_AGENT __ATOMIC_RELAXED, __HIP_MEMORY_SCOPE_AGENT
#define LDS_WAIT() asm volatile("s_waitcnt lgkmcnt(0)" ::: "memory")
#define VM_WAIT() asm volatile("s_waitcnt vmcnt(0)" ::: "memory")
typedef float f32x2_fr __attribute__((ext_vector_type(2))); typedef __bf16 bf16x2_fr __attribute__((ext_vector_type(2)));
__device__ __forceinline__ unsigned pk2(float lo, float hi) { f32x2_fr v = {lo, hi}; return __builtin_bit_cast(unsigned, __builtin_convertvector(v, bf16x2_fr)); }
__device__ __forceinline__ unsigned f2bf(float f) { return pk2(f, f) & 0xffffu; }
__device__ __forceinline__ float bf2f(bf16 b) { return __uint_as_float((unsigned)b << 16); }
__device__ __forceinline__ int lane_now() { int l; asm volatile("v_mbcnt_lo_u32_b32 %0, -1, 0\n\tv_mbcnt_hi_u32_b32 %0, -1, %0" : "=v"(l)); return l; }
__device__ __forceinline__ float wave_sum(float v) {
#pragma unroll
    for (int o = 1; o < 64; o <<= 1) v += __shfl_xor(v, o);
    return v;
}
__device__ __forceinline__ float wave_max(float v) {
#pragma unroll
    for (int o = 1; o < 64; o <<= 1) v = fmaxf(v, __shfl_xor(v, o));
    return v;
}

#define XB_TMO      128
#define XB_XCNT(j)  (256  + 64 * (j))
#define XB_XSUB(j)  (1280 + 64 * (j))
#define XB_XGEN(j)  (2304 + 64 * (j))
#define XB_TOP      3328
#define XB_TOPGEN   3392
#define XCD_BAR_WORDS 3456
#define XB_SPIN_CAP (1u << 22)

__device__ __forceinline__ unsigned xb_ld(unsigned* p)              { return __hip_atomic_load(p, __ATOMIC_RELAXED, __HIP_MEMORY_SCOPE_AGENT); }
__device__ __forceinline__ unsigned xb_add(unsigned* p, unsigned v) { return __hip_atomic_fetch_add(p, v, __ATOMIC_RELAXED, __HIP_MEMORY_SCOPE_AGENT); }
__device__ __forceinline__ unsigned xb_xcc_id() { return (unsigned)__builtin_amdgcn_s_getreg((3 << 11) | 20) & 0xFu; }
#define XB_SPIN(cond, bar) do { unsigned _sp = 0; while (cond) { __builtin_amdgcn_s_sleep(1); \
    if ((++_sp & 255u) == 0u) { if (xb_ld(&(bar)[XB_TMO])) break; if (_sp > XB_SPIN_CAP) { atomicAdd(&(bar)[XB_TMO], 1u); break; } } } } while (0)

struct XcdBarrier {
    unsigned* bar; unsigned x;
    volatile LAS unsigned* st;
};

__device__ __forceinline__ XcdBarrier xcd_barrier_post(unsigned* bar, volatile LAS unsigned* st) {
    XcdBarrier b; b.bar = bar; b.x = xb_xcc_id(); b.st = st;
    if (threadIdx.x == 0) (void)xb_add(&bar[XB_XCNT(b.x)], 1u);
    return b;
}
__device__ __forceinline__ void xcd_barrier_complete(unsigned* bar, unsigned x, unsigned& nloc, unsigned& nx) {
    const unsigned G = gridDim.x * gridDim.y * gridDim.z;
    unsigned sum, cnt, mine, sp = 0u;
    for (;;) {
        sum = 0u; cnt = 0u; mine = 0u;
#pragma unroll
        for (unsigned j = 0; j < 16; ++j) { const unsigned c = xb_ld(&bar[XB_XCNT(j)]); sum += c; cnt += (c > 0u) ? 1u : 0u; mine = (j == x) ? c : mine; }
        if (sum == G) break;
        __builtin_amdgcn_s_sleep(1);
        if ((++sp & 255u) == 0u) { if (xb_ld(&bar[XB_TMO])) break; if (sp > XB_SPIN_CAP) { atomicAdd(&bar[XB_TMO], 1u); break; } }
    }
    nloc = mine > 0u ? mine : 1u; nx = cnt > 0u ? cnt : 1u;
}

__device__ __forceinline__ void xcd_barrier(const XcdBarrier& b, int tid) {
    asm volatile("s_waitcnt vmcnt(0)" ::: "memory");
    __syncthreads();
    if (tid == 0) {
        unsigned* bar = b.bar; asm volatile("" : "+s"(bar));
        __builtin_amdgcn_s_waitcnt(0);
        unsigned bx_ = b.x; asm volatile("" : "+s"(bx_));
        unsigned nloc = b.st[0], nx = b.st[1];
        if (nloc == 0u) { xcd_barrier_complete(bar, bx_, nloc, nx); b.st[0] = nloc; b.st[1] = nx; }
        const unsigned old = xb_add(&bar[XB_XSUB(bx_)], 1u);
        const unsigned gen = old / nloc;
        if (old + 1u == (gen + 1u) * nloc) {
            __builtin_amdgcn_fence(__ATOMIC_RELEASE, "agent");
            asm volatile("s_waitcnt vmcnt(0)" ::: "memory");
            const unsigned og = xb_add(&bar[XB_TOP], 1u);
            const unsigned tg = og / nx;
            if (og + 1u == (tg + 1u) * nx) xb_add(&bar[XB_TOPGEN], 1u);
            else XB_SPIN(xb_ld(&bar[XB_TOPGEN]) == tg, bar);
            __builtin_amdgcn_fence(__ATOMIC_ACQUIRE, "agent");
            xb_add(&bar[XB_XGEN(bx_)], 1u);
            asm volatile("s_waitcnt vmcnt(0)" ::: "memory");
        } else {
            XB_SPIN(xb_ld(&bar[XB_XGEN(bx_)]) == gen, bar);
            __builtin_amdgcn_fence(__ATOMIC_ACQUIRE, "agent");
            asm volatile("s_waitcnt vmcnt(0)" ::: "memory");
        }
    }
    __syncthreads();
}

namespace mix {
typedef float f32x16 __attribute__((ext_vector_type(16)));
typedef short s16x4 __attribute__((ext_vector_type(4)));
typedef short v4i16_t __attribute__((ext_vector_type(4)));
typedef unsigned u32x2 __attribute__((ext_vector_type(2)));
typedef LAS const char* lcp;
__device__ __forceinline__ int crow(int r, int hi) { return (r & 3) + 8 * (r >> 2) + 4 * hi; }
__device__ __forceinline__ s16x4 vtr(lcp p) { return __builtin_bit_cast(s16x4, __builtin_amdgcn_ds_read_tr16_b64_v4i16((LAS v4i16_t*)p)); }
__device__ __forceinline__ bf16x8 cat8(s16x4 lo, s16x4 hi) { return (bf16x8){lo[0], lo[1], lo[2], lo[3], hi[0], hi[1], hi[2], hi[3]}; }
typedef float f32x2_t __attribute__((ext_vector_type(2))); typedef __bf16 bf16x2_t __attribute__((ext_vector_type(2)));
__device__ __forceinline__ unsigned cvtpk(float lo, float hi) { f32x2_t v = {lo, hi}; bf16x2_t b = __builtin_convertvector(v, bf16x2_t); return __builtin_bit_cast(unsigned, b); }
__device__ __forceinline__ bf16x8 pack8f(const float* v) { v4u w; w.x = cvtpk(v[0], v[1]); w.y = cvtpk(v[2], v[3]); w.z = cvtpk(v[4], v[5]); w.w = cvtpk(v[6], v[7]); return __builtin_bit_cast(bf16x8, w); }
__device__ __forceinline__ float blo(unsigned w) { return __uint_as_float(w << 16); }
__device__ __forceinline__ float bhi(unsigned w) { return __uint_as_float(w & 0xffff0000u); }
__device__ __forceinline__ float ex2(float x) { return __builtin_amdgcn_exp2f(x); }

constexpr int VP = 320;
constexpr int ATT_LUT = 32 * VP, ATT_WAVE_LDS = 32 * VP + 768;
__device__ __forceinline__ void attn_item(int it, int lane_, LAS char* vbuf, const bf16* AQ, const bf16* AK, const bf16* AV, const float* BI, bf16* OP, float* LSE) {
    const int n = it >> 10, rem = it & 1023, g = rem >> 8, blk = rem & 255, dsh = 2 * n, dil = 1 << dsh, mb = blk & ((256 >> dsh) - 1), c = blk >> (8 - dsh), Lsub = SEQ >> dsh, m0 = mb * 32, hd = 4 * n + g;
    int lane = lane_; asm volatile("" : "+v"(lane));
    const int r32 = lane & 31, hi = lane >> 5;
    LAS float* lut = (LAS float*)(vbuf + ATT_LUT);
#pragma unroll
    for (int i = 0; i < 3; ++i) lut[lane + 64 * i] = BI[hd * 192 + lane + 64 * i];
    constexpr int KPA = 272;
    bf16x8 qf[8]; v4u kst[2][8];
#define ATT_KLOAD(buf, kt) do { _Pragma("unroll") for (int i = 0; i < 8; ++i) { int km_ = m0 - 64 + 32 * (kt) + i * 4 + (lane >> 4); km_ = km_ < 0 ? 0 : (km_ >= Lsub ? Lsub - 1 : km_); \
        kst[buf][i] = *(const v4u*)(AK + (size_t)(km_ * dil + c) * AW + hd * 128 + 8 * (lane & 15)); } } while (0)
#define ATT_VLOAD(buf, kt) do { _Pragma("unroll") for (int i = 0; i < 8; ++i) { int km_ = m0 - 64 + 32 * (kt) + i * 4 + (lane >> 4); km_ = km_ < 0 ? 0 : (km_ >= Lsub ? Lsub - 1 : km_); \
        vv[buf][i] = *(const v4u*)(AV + (size_t)(km_ * dil + c) * AW + hd * 128 + 8 * (lane & 15)); } } while (0)
    { v4u qs[8];
#pragma unroll
      for (int i = 0; i < 8; ++i) qs[i] = *(const v4u*)(AQ + (size_t)((m0 + i * 4 + (lane >> 4)) * dil + c) * AW + hd * 128 + 8 * (lane & 15));
      ATT_KLOAD(0, 0); ATT_KLOAD(1, 1);
#pragma unroll
      for (int i = 0; i < 8; ++i) *(LAS v4u*)(vbuf + (i * 4 + (lane >> 4)) * KPA + (lane & 15) * 16) = qs[i];
      asm volatile("s_waitcnt lgkmcnt(0)" ::: "memory");
#pragma unroll
      for (int d0 = 0; d0 < 8; ++d0) qf[d0] = *(const LAS bf16x8*)(vbuf + r32 * KPA + 32 * d0 + 16 * hi); }
    f32x16 sT[5];
#pragma unroll
    for (int kt = 0; kt < 5; ++kt) {
        asm volatile("s_waitcnt lgkmcnt(0)" ::: "memory");
#pragma unroll
        for (int i = 0; i < 8; ++i) *(LAS v4u*)(vbuf + (i * 4 + (lane >> 4)) * KPA + (lane & 15) * 16) = kst[kt & 1][i];
        if (kt < 3) ATT_KLOAD(kt & 1, kt + 2);
        asm volatile("s_waitcnt lgkmcnt(0)" ::: "memory");
        bf16x8 kfr[8];
#pragma unroll
        for (int d0 = 0; d0 < 8; ++d0) kfr[d0] = *(const LAS bf16x8*)(vbuf + r32 * KPA + 32 * d0 + 16 * hi);
        f32x16 acc = {0.f, 0.f, 0.f, 0.f, 0.f, 0.f, 0.f, 0.f, 0.f, 0.f, 0.f, 0.f, 0.f, 0.f, 0.f, 0.f};
#pragma unroll
        for (int d0 = 0; d0 < 8; ++d0) acc = __builtin_amdgcn_mfma_f32_32x32x16_bf16(kfr[d0], qf[d0], acc, 0, 0, 0);
        sT[kt] = acc;
    }
    v4u vv[2][8];
    ATT_VLOAD(0, 0); ATT_VLOAD(1, 1);
    const LAS float* bl = lut + (32 + 4 * hi - r32);
    const int klo = 64 - m0, khi = Lsub + 64 - m0;
#pragma unroll
    for (int kt = 0; kt < 5; ++kt)
#pragma unroll
        for (int r = 0; r < 16; ++r) sT[kt][r] += bl[32 * kt + (r & 3) + 8 * (r >> 2)];
    if (klo > 0 || khi < 160) {
#pragma unroll
        for (int kt = 0; kt < 5; ++kt)
#pragma unroll
            for (int r = 0; r < 16; ++r) { const int kk = 32 * kt + (r & 3) + 8 * (r >> 2) + 4 * hi; sT[kt][r] = ((kk >= klo) && (kk < khi)) ? sT[kt][r] : -1e30f; }
    }
    float mx = -1e30f;
#pragma unroll
    for (int kt = 0; kt < 5; ++kt)
#pragma unroll
        for (int r = 0; r < 16; ++r) mx = fmaxf(mx, sT[kt][r]);
    mx = fmaxf(mx, __shfl_xor(mx, 32));
    float sum = 0.f;
#pragma unroll
    for (int kt = 0; kt < 5; ++kt)
#pragma unroll
        for (int r = 0; r < 16; ++r) { const float p = ex2(sT[kt][r] - mx); sT[kt][r] = p; sum += p; }
    sum += __shfl_xor(sum, 32);
    bf16x8 pa[5][2];
#pragma unroll
    for (int kt = 0; kt < 5; ++kt)
#pragma unroll
        for (int s16 = 0; s16 < 2; ++s16) { float pv[8];
#pragma unroll
            for (int j = 0; j < 8; ++j) pv[j] = sT[kt][8 * s16 + j];
            pa[kt][s16] = pack8f(pv); }
    f32x16 o[4];
#pragma unroll
    for (int db = 0; db < 4; ++db) o[db] = (f32x16){0.f, 0.f, 0.f, 0.f, 0.f, 0.f, 0.f, 0.f, 0.f, 0.f, 0.f, 0.f, 0.f, 0.f, 0.f, 0.f};
    const int q4 = (lane & 15) >> 2, p4 = lane & 3, g1 = (lane >> 4) & 1;
    lcp vrd = (lcp)vbuf + (4 * hi + q4) * VP + (16 * g1 + 4 * p4) * 2;
#pragma unroll
    for (int kt = 0; kt < 5; ++kt) {
        asm volatile("s_waitcnt lgkmcnt(0)" ::: "memory");
#pragma unroll
        for (int i = 0; i < 8; ++i) *(LAS v4u*)(vbuf + (i * 4 + (lane >> 4)) * VP + (lane & 15) * 16) = vv[kt & 1][i];
        if (kt < 3) ATT_VLOAD(kt & 1, kt + 2);
        asm volatile("s_waitcnt lgkmcnt(0)" ::: "memory");
#pragma unroll
        for (int s16 = 0; s16 < 2; ++s16)
#pragma unroll
            for (int db = 0; db < 4; ++db) {
                const s16x4 lo = vtr(vrd + (16 * s16) * VP + 64 * db), hh = vtr(vrd + (16 * s16 + 8) * VP + 64 * db);
                o[db] = __builtin_amdgcn_mfma_f32_32x32x16_bf16(pa[kt][s16], cat8(lo, hh), o[db], 0, 0, 0);
            }
    }
#undef ATT_KLOAD
#undef ATT_VLOAD
    const float linv = 1.0f / sum;
#pragma unroll
    for (int r = 0; r < 16; ++r) {
        const int qr = crow(r, hi); const float li = __shfl(linv, qr);
        bf16* op = OP + ((size_t)n * SEQ + (size_t)((m0 + qr) * dil + c)) * AOW + g * 128 + r32;
#pragma unroll
        for (int db = 0; db < 4; ++db) op[32 * db] = (bf16)f2bf(o[db][r] * li);
    }
    if (hi == 0) LSE[((size_t)n * SEQ + (size_t)((m0 + r32) * dil + c)) * 4 + g] = mx + __builtin_amdgcn_logf(sum);
}
__device__ __forceinline__ void attn_combine(int gtid, int nthreads, const bf16* OP, const float* LSE, bf16* OA) {
    for (int idx = gtid; idx < SEQ * (AOW / 8); idx += nthreads) {
        const int p = idx >> 6, c8 = idx & 63, g = c8 >> 4;
        const float l0 = LSE[((size_t)0 * SEQ + p) * 4 + g], l1 = LSE[((size_t)1 * SEQ + p) * 4 + g], l2 = LSE[((size_t)2 * SEQ + p) * 4 + g];
        const float ml = fmaxf(l0, fmaxf(l1, l2)); float w0 = ex2(l0 - ml), w1 = ex2(l1 - ml), w2 = ex2(l2 - ml); const float wi = 1.0f / (w0 + w1 + w2); w0 *= wi; w1 *= wi; w2 *= wi;
        const v4u a = *(const v4u*)(OP + ((size_t)0 * SEQ + p) * AOW + c8 * 8), b = *(const v4u*)(OP + ((size_t)1 * SEQ + p) * AOW + c8 * 8), cc = *(const v4u*)(OP + ((size_t)2 * SEQ + p) * AOW + c8 * 8);
        v4u o;
        o.x = cvtpk(w0 * blo(a.x) + w1 * blo(b.x) + w2 * blo(cc.x), w0 * bhi(a.x) + w1 * bhi(b.x) + w2 * bhi(cc.x));
        o.y = cvtpk(w0 * blo(a.y) + w1 * blo(b.y) + w2 * blo(cc.y), w0 * bhi(a.y) + w1 * bhi(b.y) + w2 * bhi(cc.y));
        o.z = cvtpk(w0 * blo(a.z) + w1 * blo(b.z) + w2 * blo(cc.z), w0 * bhi(a.z) + w1 * bhi(b.z) + w2 * bhi(cc.z));
        o.w = cvtpk(w0 * blo(a.w) + w1 * blo(b.w) + w2 * blo(cc.w), w0 * bhi(a.w) + w1 * bhi(b.w) + w2 * bhi(cc.w));
        *(v4u*)(OA + (size_t)p * OAW + HW + c8 * 8) = o;
    }
}

constexpr int KP = 320;
constexpr int H1_KHF = 0, H1_KHB = 64 * KP, H1_VV = 2 * 64 * KP, H1_TOT = 3 * 64 * KP;
__device__ __forceinline__ size_t st_tile(int d, int h, int c, int tile) { return ((((size_t)(d * NHH + h)) * 128 + c) * 16 + tile) * 1024; }
constexpr int H1_LFF = H1_TOT + 4096, H1_LFB = H1_LFF + 64 * 132 * 4, H1_END = H1_LFB + 64 * 132 * 4;
static_assert(H1_END <= MIX_LDS_BYTES, "H1 LDS map");
__device__ __forceinline__ unsigned key2(unsigned w) { return cvtpk(1.0f - ex2(blo(w)), 1.0f - ex2(bhi(w))); }
__device__ __forceinline__ v4u keys_of(v4u w) { v4u o; o.x = key2(w.x); o.y = key2(w.y); o.z = key2(w.z); o.w = key2(w.w); return o; }
struct H1Pre { v4u lf[4]; v4u kv[2]; };
__device__ __forceinline__ void h1_load(int u, int tid, const bf16* Kf, const bf16* Kb, const bf16* LFf, const bf16* LFb, const bf16* Vh, H1Pre& P) {
    const int h = u & 7, c = u >> 3, t0 = c * 64;
#pragma unroll
    for (int i = 0; i < 2; ++i) { const int idx = tid + 512 * i, row = idx >> 4, c16 = idx & 15; const size_t go = (size_t)(t0 + row) * HW + h * HKD + 8 * c16;
        P.lf[i] = *(const v4u*)(LFf + go); P.lf[2 + i] = *(const v4u*)(LFb + go);
        P.kv[i] = *(const v4u*)(Vh + go); }
}
__device__ __forceinline__ void h1_unit(int u, LAS char* L, int tid, const bf16* Kf, const bf16* Kb, const bf16* LFf, const bf16* LFb, const bf16* Vh, bf16* SU, float* DD, int un, H1Pre& P) {
    const int h = u & 7, c = u >> 3, lane = tid & 63, w = __builtin_amdgcn_readfirstlane(tid >> 6), k = lane + 64 * (w & 1), tq = w >> 1;
    LAS float* TOT = (LAS float*)(L + H1_TOT); LAS float* LFF = (LAS float*)(L + H1_LFF); LAS float* LFB = (LAS float*)(L + H1_LFB);
#pragma unroll
    for (int i = 0; i < 2; ++i) { const int idx = tid + 512 * i, row = idx >> 4, c16 = idx & 15; const v4u a = P.lf[i], b = P.lf[2 + i];
        *(LAS f32x4*)(LFF + row * 132 + 8 * c16) = (f32x4){blo(a.x), bhi(a.x), blo(a.y), bhi(a.y)}; *(LAS f32x4*)(LFF + row * 132 + 8 * c16 + 4) = (f32x4){blo(a.z), bhi(a.z), blo(a.w), bhi(a.w)};
        *(LAS f32x4*)(LFB + row * 132 + 8 * c16) = (f32x4){blo(b.x), bhi(b.x), blo(b.y), bhi(b.y)}; *(LAS f32x4*)(LFB + row * 132 + 8 * c16 + 4) = (f32x4){blo(b.z), bhi(b.z), blo(b.w), bhi(b.w)};
        *(LAS v4u*)(L + H1_VV + row * KP + c16 * 16) = P.kv[i]; }
    h1_load(un, tid, Kf, Kb, LFf, LFb, Vh, P);
    __syncthreads();
    float pf[16], pb[16];
    { float sa = 0.f, sb = 0.f;
#pragma unroll
      for (int i = 0; i < 16; ++i) { sa += LFF[(16 * tq + i) * 132 + k]; pf[i] = sa; sb += LFB[(16 * tq + i) * 132 + k]; pb[i] = sb; } }
    TOT[(0 * 4 + tq) * 128 + k] = pf[15]; TOT[(1 * 4 + tq) * 128 + k] = pb[15];
    __syncthreads();
    float sufF = 0.f, preB = 0.f, totF = 0.f, totB = 0.f;
#pragma unroll
    for (int q = 0; q < 4; ++q) { const float tf = TOT[(0 * 4 + q) * 128 + k], tb = TOT[(1 * 4 + q) * 128 + k]; totF += tf; totB += tb; if (q > tq) sufF += tf; if (q < tq) preB += tb; }
    { float Ff[16], Fb[16], Gf[16];
#pragma unroll
      for (int i = 0; i < 16; ++i) { Ff[i] = ex2(pf[i] - (i ? pf[i - 1] : 0.f)); Fb[i] = ex2(pb[i] - (i ? pb[i - 1] : 0.f)); }
      Gf[15] = ex2(sufF);
#pragma unroll
      for (int i = 14; i >= 0; --i) Gf[i] = Gf[i + 1] * Ff[i + 1];
      float gb = ex2(preB);
#pragma unroll
      for (int i = 0; i < 16; ++i) {
          LAS bf16* pkf = (LAS bf16*)(L + H1_KHF + (16 * tq + i) * KP + k * 2); LAS bf16* pkb = (LAS bf16*)(L + H1_KHB + (16 * tq + i) * KP + k * 2);
          *pkf = (bf16)f2bf((1.0f - Ff[i]) * Gf[i]); *pkb = (bf16)f2bf((1.0f - Fb[i]) * gb); gb *= Fb[i];
      } }
    if (tq == 0) { DD[((size_t)(0 * NHH + h) * 128 + c) * 128 + k] = ex2(totF); DD[((size_t)(1 * NHH + h) * 128 + c) * 128 + k] = ex2(totB); }
    __syncthreads();
    const int hi = lane >> 5, q4 = (lane & 15) >> 2, p4 = lane & 3, g1 = (lane >> 4) & 1, kt = w & 3, vh = w >> 2;
#pragma unroll
    for (int d = 0; d < 2; ++d) {
        lcp ab = (lcp)L + (d ? H1_KHB : H1_KHF) + (8 * hi + q4) * KP + (32 * kt + 16 * g1 + 4 * p4) * 2;
        lcp bb = (lcp)L + H1_VV + (8 * hi + q4) * KP + (64 * vh + 16 * g1 + 4 * p4) * 2;
        f32x16 acc0 = {0.f, 0.f, 0.f, 0.f, 0.f, 0.f, 0.f, 0.f, 0.f, 0.f, 0.f, 0.f, 0.f, 0.f, 0.f, 0.f}, acc1 = acc0;
#pragma unroll
        for (int st = 0; st < 4; ++st) {
            const bf16x8 af = cat8(vtr(ab + 16 * st * KP), vtr(ab + (16 * st + 4) * KP));
            const bf16x8 b0 = cat8(vtr(bb + 16 * st * KP), vtr(bb + (16 * st + 4) * KP));
            const bf16x8 b1 = cat8(vtr(bb + 16 * st * KP + 64), vtr(bb + (16 * st + 4) * KP + 64));
            acc0 = __builtin_amdgcn_mfma_f32_32x32x16_bf16(af, b0, acc0, 0, 0, 0);
            acc1 = __builtin_amdgcn_mfma_f32_32x32x16_bf16(af, b1, acc1, 0, 0, 0);
        }
        float t[16];
#pragma unroll
        for (int r = 0; r < 16; ++r) t[r] = acc0[r];
        bf16* o0 = SU + st_tile(d, h, c, kt * 4 + 2 * vh) + lane * 16;
        *(bf16x8*)o0 = pack8f(t); *(bf16x8*)(o0 + 8) = pack8f(t + 8);
#pragma unroll
        for (int r = 0; r < 16; ++r) t[r] = acc1[r];
        bf16* o1 = SU + st_tile(d, h, c, kt * 4 + 2 * vh + 1) + lane * 16;
        *(bf16x8*)o1 = pack8f(t); *(bf16x8*)(o1 + 8) = pack8f(t + 8);
    }
    __syncthreads();
}
constexpr int H2_DL = 90112, H2_DL_WAVE = 16384;
static_assert(H2_DL >= 8 * ATT_WAVE_LDS && H2_DL + 2 * H2_DL_WAVE <= MIX_LDS_BYTES, "H2 LDS map");
__device__ __forceinline__ void h2_scan(int gid, bf16* SU, const float* DD, LAS float* dl, int l64) {
    const int e8 = gid & 127, tile = (gid >> 7) & 15, dh = gid >> 11, d = dh >> 3, lane = e8 >> 1, r0 = (e8 & 1) * 8, kt = tile >> 2, k0 = crow(r0, lane >> 5);
    bf16* base = SU + ((size_t)dh * 128 * 16 + tile) * 1024 + e8 * 8; const float* dsrc = DD + (size_t)dh * 128 * 128 + kt * 32;
#pragma unroll
    for (int b = 0; b < 2; ++b) { f32x4 t[8];
#pragma unroll
        for (int i = 0; i < 8; ++i) { const int idx = l64 + 64 * (8 * b + i); t[i] = *(const f32x4*)(dsrc + (size_t)(idx >> 3) * 128 + 4 * (idx & 7)); }
#pragma unroll
        for (int i = 0; i < 8; ++i) { const int idx = l64 + 64 * (8 * b + i); *(LAS f32x4*)(dl + idx * 4) = t[i]; } }
    asm volatile("s_waitcnt lgkmcnt(0)" ::: "memory");
    const LAS float* dq = dl + k0;
    float s[8] = {0.f, 0.f, 0.f, 0.f, 0.f, 0.f, 0.f, 0.f};
    v4u ua[8], ub[8];
#define H2_LOAD(U, sb) _Pragma("unroll") for (int j = 0; j < 8; ++j) { const int c = d ? 127 - ((sb) + j) : (sb) + j; U[j] = *(const v4u*)(base + (size_t)c * 16 * 1024); }
#define H2_STEP(U, sb) _Pragma("unroll") for (int j = 0; j < 8; ++j) { const int c = d ? 127 - ((sb) + j) : (sb) + j; \
        v4u o; o.x = cvtpk(s[0], s[1]); o.y = cvtpk(s[2], s[3]); o.z = cvtpk(s[4], s[5]); o.w = cvtpk(s[6], s[7]); *(v4u*)(base + (size_t)c * 16 * 1024) = o; \
        const f32x4 d0 = *(const LAS f32x4*)(dq + c * 32), d1 = *(const LAS f32x4*)(dq + c * 32 + 8); \
        s[0] = d0[0] * s[0] + blo(U[j].x); s[1] = d0[1] * s[1] + bhi(U[j].x); s[2] = d0[2] * s[2] + blo(U[j].y); s[3] = d0[3] * s[3] + bhi(U[j].y); \
        s[4] = d1[0] * s[4] + blo(U[j].z); s[5] = d1[1] * s[5] + bhi(U[j].z); s[6] = d1[2] * s[6] + blo(U[j].w); s[7] = d1[3] * s[7] + bhi(U[j].w); }
    H2_LOAD(ua, 0)
    for (int sb = 0; sb < 128; sb += 16) {
        H2_LOAD(ub, sb + 8)
        H2_STEP(ua, sb)
        if (sb + 16 < 128) { H2_LOAD(ua, sb + 16) }
        H2_STEP(ub, sb + 8)
    }
#undef H2_LOAD
#undef H2_STEP
}
constexpr int PHP = 132;
constexpr int H3_PHF = 0, H3_PHB = 64 * PHP * 4, H3_QQ = 2 * 64 * PHP * 4, QP = 272, H3_VV = H3_QQ + 64 * QP, H3_AA = H3_VV + 64 * KP, AP = 144, H3_TOT = H3_AA + 64 * AP, H3_QI = H3_TOT + 4096, H3_END = H3_QI + 2 * 64 * QP;
constexpr int H3_ON = 0;
static_assert(H3_END <= MIX_LDS_BYTES, "H3 LDS map");
struct H3Pre { v4u lf[4]; v4u qv[4]; };
__device__ __forceinline__ void h3_lf_load(int u, int tid, const bf16* LFf, const bf16* LFb, const bf16* Qh, const bf16* Vh, H3Pre& P) {
    const int h = u & 7, c = u >> 3, t0 = c * 64;
#pragma unroll
    for (int i = 0; i < 2; ++i) { const int idx = tid + 512 * i, row = idx >> 4, c16 = idx & 15;
        P.lf[i] = *(const v4u*)(LFf + (size_t)(t0 + row) * HW + h * HKD + 8 * c16); P.lf[2 + i] = *(const v4u*)(LFb + (size_t)(t0 + row) * HW + h * HKD + 8 * c16); }
#pragma unroll
    for (int i = 0; i < 2; ++i) { const int idx = tid + 512 * i, row = idx >> 4, c16 = idx & 15;
        P.qv[i] = *(const v4u*)(Vh + (size_t)(t0 + row) * HW + h * HKD + 8 * c16); P.qv[2 + i] = *(const v4u*)(Qh + (size_t)(t0 + row) * HW + h * HKD + 8 * c16); }
}
__device__ __forceinline__ void h3_unit(int u, LAS char* L, int tid, const bf16* Qh, const bf16* Kf, const bf16* Kb, const bf16* LFf, const bf16* LFb, const bf16* Vh, const bf16* Gs,
                                        const bf16* SU, const float* nw, bf16* OA, int un, H3Pre& P) {
    const int h = u & 7, c = u >> 3, t0 = c * 64, lane = tid & 63, w = __builtin_amdgcn_readfirstlane(tid >> 6), k = lane + 64 * (w & 1), tq = w >> 1;
    const int hi = lane >> 5, r32 = lane & 31, q4 = (lane & 15) >> 2, p4 = lane & 3, g1 = (lane >> 4) & 1, tt = w & 1, vt = w >> 1;
    const int r16 = lane & 15, kq = lane >> 4;
    LAS float* TOT = (LAS float*)(L + H3_TOT); LAS float* PHF = (LAS float*)(L + H3_PHF); LAS float* PHB = (LAS float*)(L + H3_PHB);
#pragma unroll
    for (int i = 0; i < 2; ++i) { const int idx = tid + 512 * i, row = idx >> 4, c16 = idx & 15;
        *(LAS v4u*)(L + H3_VV + row * KP + c16 * 16) = P.qv[i]; *(LAS v4u*)(L + H3_QQ + row * QP + c16 * 16) = P.qv[2 + i]; }
#pragma unroll
    for (int i = 0; i < 2; ++i) { const int idx = tid + 512 * i, row = idx >> 4, c16 = idx & 15; const v4u a = P.lf[i], b = P.lf[2 + i];
        *(LAS f32x4*)(PHF + row * PHP + 8 * c16) = (f32x4){blo(a.x), bhi(a.x), blo(a.y), bhi(a.y)}; *(LAS f32x4*)(PHF + row * PHP + 8 * c16 + 4) = (f32x4){blo(a.z), bhi(a.z), blo(a.w), bhi(a.w)};
        *(LAS f32x4*)(PHB + row * PHP + 8 * c16) = (f32x4){blo(b.x), bhi(b.x), blo(b.y), bhi(b.y)}; *(LAS f32x4*)(PHB + row * PHP + 8 * c16 + 4) = (f32x4){blo(b.z), bhi(b.z), blo(b.w), bhi(b.w)}; }
    const int jd = w & 3, dd0 = w >> 2;
    __syncthreads();
    float pf[16], pb[16];
    { float sa = 0.f, sb = 0.f;
#pragma unroll
      for (int i = 0; i < 16; ++i) { sa += PHF[(16 * tq + i) * PHP + k]; pf[i] = sa; sb += PHB[(16 * tq + i) * PHP + k]; pb[i] = sb; } }
    TOT[(0 * 4 + tq) * 128 + k] = pf[15]; TOT[(1 * 4 + tq) * 128 + k] = pb[15];
    LAS unsigned* FL = (LAS unsigned*)(L + MISC_OFF) + 24;
    { const bool okw = __all((pf[15] >= -25.0f) && (pb[15] >= -25.0f)); if (lane == 0) FL[w] = okw ? 1u : 0u; }
    __syncthreads();
    bool fast; { unsigned f8 = 1u;
#pragma unroll
      for (int i = 0; i < 8; ++i) f8 &= FL[i];
      fast = __builtin_amdgcn_readfirstlane((int)f8) != 0; }
    LAS char* KI = L + H3_PHF;
    if (fast) { float preF = 0.f, sufB = 0.f;
#pragma unroll
      for (int q = 0; q < 4; ++q) { const float tf = TOT[(0 * 4 + q) * 128 + k], tb = TOT[(1 * 4 + q) * 128 + k]; if (q < tq) preF += tf; if (q > tq) sufB += tb; }
      float Ff[16], Fb[16], Eb[16];
#pragma unroll
      for (int i = 0; i < 16; ++i) { Ff[i] = ex2(pf[i] - (i ? pf[i - 1] : 0.f)); Fb[i] = ex2(pb[i] - (i ? pb[i - 1] : 0.f)); }
      Eb[15] = ex2(sufB) * Fb[15];
#pragma unroll
      for (int i = 14; i >= 0; --i) Eb[i] = Eb[i + 1] * Fb[i];
      float efc = ex2(preF);
#pragma unroll
      for (int i = 0; i < 16; ++i) { const int t = 16 * tq + i; efc *= Ff[i];
          const float qv = bf2f(*(const LAS bf16*)(L + H3_QQ + t * QP + k * 2));
          *(LAS bf16*)(L + H3_QI + t * QP + k * 2) = (bf16)f2bf(qv * efc); *(LAS bf16*)(L + H3_QI + 64 * QP + t * QP + k * 2) = (bf16)f2bf(qv * Eb[i]);
          *(LAS bf16*)(KI + t * QP + k * 2) = (bf16)f2bf((1.0f - Ff[i]) * __builtin_amdgcn_rcpf(efc)); *(LAS bf16*)(KI + 64 * QP + t * QP + k * 2) = (bf16)f2bf((1.0f - Fb[i]) * __builtin_amdgcn_rcpf(Eb[i])); } }
    else
    { float preF = 0.f, sufB = 0.f;
#pragma unroll
      for (int q = 0; q < 4; ++q) { const float tf = TOT[(0 * 4 + q) * 128 + k], tb = TOT[(1 * 4 + q) * 128 + k]; if (q < tq) preF += tf; if (q > tq) sufB += tb; }
#pragma unroll
      for (int i = 0; i < 16; ++i) { const int t = 16 * tq + i; const float phf = preF + pf[i], phb = sufB + (pb[15] - (i ? pb[i - 1] : 0.f));
          PHF[t * PHP + k] = phf; PHB[t * PHP + k] = phb;
          const float qv = bf2f(*(const LAS bf16*)(L + H3_QQ + t * QP + k * 2));
          *(LAS bf16*)(L + H3_QI + t * QP + k * 2) = (bf16)f2bf(qv * ex2(phf)); *(LAS bf16*)(L + H3_QI + 64 * QP + t * QP + k * 2) = (bf16)f2bf(qv * ex2(phb)); } }
    __syncthreads();
    h3_lf_load(un, tid, LFf, LFb, Qh, Vh, P);
    bf16x8 sfr[4][2];
    if (fast) {
#pragma unroll
        for (int kt2 = 0; kt2 < 4; ++kt2) { const bf16* sp = SU + st_tile(0, h, c, kt2 * 4 + vt) + lane * 16; sfr[kt2][0] = *(const bf16x8*)sp; sfr[kt2][1] = *(const bf16x8*)(sp + 8); }
        if (w < 4) { const int ti = (w == 0 || w == 3) ? 0 : 1, sj = (w == 0 || w == 2) ? 0 : 1;
            f32x16 af = {0.f, 0.f, 0.f, 0.f, 0.f, 0.f, 0.f, 0.f, 0.f, 0.f, 0.f, 0.f, 0.f, 0.f, 0.f, 0.f}, ab = af;
            if (w != 3) {
#pragma unroll
                for (int ks = 0; ks < 8; ++ks) af = __builtin_amdgcn_mfma_f32_32x32x16_bf16(*(const LAS bf16x8*)(KI + (32 * sj + r32) * QP + (16 * ks + 8 * hi) * 2), *(const LAS bf16x8*)(L + H3_QI + (32 * ti + r32) * QP + (16 * ks + 8 * hi) * 2), af, 0, 0, 0); }
            if (w != 2) {
#pragma unroll
                for (int ks = 0; ks < 8; ++ks) ab = __builtin_amdgcn_mfma_f32_32x32x16_bf16(*(const LAS bf16x8*)(KI + 64 * QP + (32 * sj + r32) * QP + (16 * ks + 8 * hi) * 2), *(const LAS bf16x8*)(L + H3_QI + 64 * QP + (32 * ti + r32) * QP + (16 * ks + 8 * hi) * 2), ab, 0, 0, 0); }
            const int tl = r32;
#pragma unroll
            for (int rq = 0; rq < 4; ++rq) { float o4[4];
#pragma unroll
                for (int j = 0; j < 4; ++j) { const int r = 4 * rq + j, sl = crow(r, hi);
                    o4[j] = (w < 2) ? ((sl <= tl ? af[r] : 0.f) + (sl >= tl ? ab[r] : 0.f)) : (w == 2 ? af[r] : ab[r]); }
                u32x2 o2; o2.x = cvtpk(o4[0], o4[1]); o2.y = cvtpk(o4[2], o4[3]);
                *(LAS u32x2*)(L + H3_AA + (32 * ti + tl) * AP + (32 * sj + 8 * rq + 4 * hi) * 2) = o2; }
        }
    } else {
    v4u ka[4], kb2[4];
#pragma unroll
    for (int i = 0; i < 4; ++i) { ka[i] = keys_of(*(const v4u*)((dd0 ? LFb : LFf) + (size_t)(t0 + 16 * jd + r16) * HW + h * HKD + 32 * i + 8 * kq)); kb2[i] = keys_of(*(const v4u*)((dd0 ? LFf : LFb) + (size_t)(t0 + 16 * jd + r16) * HW + h * HKD + 32 * i + 8 * kq)); }
    {
    { const int dd = dd0, s = 16 * jd + r16; const LAS float* PH = dd ? PHB : PHF;
      float ps[32];
#pragma unroll
      for (int i = 0; i < 4; ++i) { const f32x4 x = *(const LAS f32x4*)(PH + s * PHP + 32 * i + 8 * kq), y = *(const LAS f32x4*)(PH + s * PHP + 32 * i + 8 * kq + 4);
          ps[8 * i] = x[0]; ps[8 * i + 1] = x[1]; ps[8 * i + 2] = x[2]; ps[8 * i + 3] = x[3]; ps[8 * i + 4] = y[0]; ps[8 * i + 5] = y[1]; ps[8 * i + 6] = y[2]; ps[8 * i + 7] = y[3]; }
#define H3_KK(i, j) (((j) & 1) ? bhi(ka[i][(j) >> 1]) : blo(ka[i][(j) >> 1]))
      const int R0 = dd ? 16 * jd + 15 : 16 * jd;
      bool small = true;
#pragma unroll
      for (int i = 0; i < 4; ++i) { const f32x4 x = *(const LAS f32x4*)(PH + R0 * PHP + 32 * i + 8 * kq), y = *(const LAS f32x4*)(PH + R0 * PHP + 32 * i + 8 * kq + 4);
          const float r0v[8] = {x[0], x[1], x[2], x[3], y[0], y[1], y[2], y[3]};
#pragma unroll
          for (int j = 0; j < 8; ++j) small = small && (__builtin_fabsf(r0v[j] - ps[8 * i + j]) <= 100.0f); }
      if (__all(small)) {
          f32x4 d4 = {0.f, 0.f, 0.f, 0.f};
#pragma unroll
          for (int i = 0; i < 4; ++i) {
              const int t = 16 * jd + r16;
              const f32x4 x = *(const LAS f32x4*)(PH + t * PHP + 32 * i + 8 * kq), y = *(const LAS f32x4*)(PH + t * PHP + 32 * i + 8 * kq + 4);
              const f32x4 rx = *(const LAS f32x4*)(PH + R0 * PHP + 32 * i + 8 * kq), ry = *(const LAS f32x4*)(PH + R0 * PHP + 32 * i + 8 * kq + 4);
              const v4u qv = *(const LAS v4u*)(L + H3_QQ + t * QP + (32 * i + 8 * kq) * 2);
              const float pr0[8] = {rx[0], rx[1], rx[2], rx[3], ry[0], ry[1], ry[2], ry[3]};
              const float av[8] = {blo(qv.x) * ex2(x[0] - pr0[0]), bhi(qv.x) * ex2(x[1] - pr0[1]), blo(qv.y) * ex2(x[2] - pr0[2]), bhi(qv.y) * ex2(x[3] - pr0[3]),
                                   blo(qv.z) * ex2(y[0] - pr0[4]), bhi(qv.z) * ex2(y[1] - pr0[5]), blo(qv.w) * ex2(y[2] - pr0[6]), bhi(qv.w) * ex2(y[3] - pr0[7])};
              float bv[8];
#pragma unroll
              for (int j = 0; j < 8; ++j) bv[j] = H3_KK(i, j) * ex2(pr0[j] - ps[8 * i + j]);
              d4 = __builtin_amdgcn_mfma_f32_16x16x32_bf16(pack8f(av), pack8f(bv), d4, 0, 0, 0);
          }
#pragma unroll
          for (int r = 0; r < 4; ++r) { const int t = 16 * jd + 4 * kq + r;
              if (dd == 0 ? (s <= t) : (s > t)) *(LAS bf16*)(L + H3_AA + t * AP + s * 2) = (bf16)f2bf(d4[r]); }
      } else
      for (int tl = 0; tl < 16; ++tl) {
          const int t = 16 * jd + tl;
          f32x4 d4 = {0.f, 0.f, 0.f, 0.f};
#pragma unroll
          for (int i = 0; i < 4; ++i) {
              const f32x4 x = *(const LAS f32x4*)(PH + t * PHP + 32 * i + 8 * kq), y = *(const LAS f32x4*)(PH + t * PHP + 32 * i + 8 * kq + 4);
              const bf16x8 qr = *(const LAS bf16x8*)(L + H3_QQ + t * QP + (32 * i + 8 * kq) * 2);
              const float pt[8] = {x[0], x[1], x[2], x[3], y[0], y[1], y[2], y[3]};
              float wv[8];
#pragma unroll
              for (int j = 0; j < 8; ++j) wv[j] = H3_KK(i, j) * ex2(pt[j] - ps[8 * i + j]);
              d4 = __builtin_amdgcn_mfma_f32_16x16x32_bf16(pack8f(wv), qr, d4, 0, 0, 0);
          }
          if (r16 == 0) {
#pragma unroll
              for (int r = 0; r < 4; ++r) { const int sk = 16 * jd + 4 * kq + r; if (dd == 0 ? (sk <= t) : (sk > t)) *(LAS bf16*)(L + H3_AA + t * AP + sk * 2) = (bf16)f2bf(d4[r]); } }
      }
      if (dd == 0) {
          float e = 0.f;
#pragma unroll
          for (int i = 0; i < 4; ++i) { const v4u qv = *(const LAS v4u*)(L + H3_QQ + s * QP + (32 * i + 8 * kq) * 2);
              e += blo(qv.x) * blo(kb2[i].x) + bhi(qv.x) * bhi(kb2[i].x) + blo(qv.y) * blo(kb2[i].y) + bhi(qv.y) * bhi(kb2[i].y) + blo(qv.z) * blo(kb2[i].z) + bhi(qv.z) * bhi(kb2[i].z) + blo(qv.w) * blo(kb2[i].w) + bhi(qv.w) * bhi(kb2[i].w); }
          { int l2 = lane; asm volatile("" : "+v"(l2));
            e += __builtin_bit_cast(float, __builtin_amdgcn_ds_bpermute((l2 ^ 16) << 2, __builtin_bit_cast(int, e)));
            e += __builtin_bit_cast(float, __builtin_amdgcn_ds_bpermute((l2 ^ 32) << 2, __builtin_bit_cast(int, e))); }
          if (kq == 0) { LAS bf16* pd = (LAS bf16*)(L + H3_AA + s * AP + s * 2); *pd = (bf16)f2bf(bf2f(*pd) + e); }
      } }
#undef H3_KK
#pragma unroll
    for (int kt2 = 0; kt2 < 4; ++kt2) { const bf16* sp = SU + st_tile(0, h, c, kt2 * 4 + vt) + lane * 16; sfr[kt2][0] = *(const bf16x8*)sp; sfr[kt2][1] = *(const bf16x8*)(sp + 8); }
#pragma unroll
    for (int pass = 0; pass < 2; ++pass) { const int b = w + 8 * pass; if (b < 12) {
        const int dd = b >= 6, bb = dd ? b - 6 : b;
        const int jlo = bb < 3 ? 0 : (bb < 5 ? 1 : 2), ihi = bb < 3 ? bb + 1 : (bb < 5 ? bb - 1 : 3);
        const int i = dd ? jlo : ihi, j = dd ? ihi : jlo, R = dd ? 16 * j : 16 * j + 15;
        const LAS float* PH = dd ? PHB : PHF;
        f32x4 d4 = {0.f, 0.f, 0.f, 0.f};
#pragma unroll
        for (int st = 0; st < 4; ++st) {
            const int ko = 32 * st + 8 * kq;
            const f32x4 r0 = *(const LAS f32x4*)(PH + R * PHP + ko), r1 = *(const LAS f32x4*)(PH + R * PHP + ko + 4);
            const f32x4 a0 = *(const LAS f32x4*)(PH + (16 * i + r16) * PHP + ko), a1 = *(const LAS f32x4*)(PH + (16 * i + r16) * PHP + ko + 4);
            const f32x4 b0 = *(const LAS f32x4*)(PH + (16 * j + r16) * PHP + ko), b1 = *(const LAS f32x4*)(PH + (16 * j + r16) * PHP + ko + 4);
            const v4u qv = *(const LAS v4u*)(L + H3_QQ + (16 * i + r16) * QP + ko * 2);
            const v4u kv = keys_of(*(const v4u*)((dd ? LFb : LFf) + (size_t)(t0 + 16 * j + r16) * HW + h * HKD + ko));
            const float av[8] = {blo(qv.x) * ex2(a0[0] - r0[0]), bhi(qv.x) * ex2(a0[1] - r0[1]), blo(qv.y) * ex2(a0[2] - r0[2]), bhi(qv.y) * ex2(a0[3] - r0[3]),
                                 blo(qv.z) * ex2(a1[0] - r1[0]), bhi(qv.z) * ex2(a1[1] - r1[1]), blo(qv.w) * ex2(a1[2] - r1[2]), bhi(qv.w) * ex2(a1[3] - r1[3])};
            const float bv[8] = {blo(kv.x) * ex2(r0[0] - b0[0]), bhi(kv.x) * ex2(r0[1] - b0[1]), blo(kv.y) * ex2(r0[2] - b0[2]), bhi(kv.y) * ex2(r0[3] - b0[3]),
                                 blo(kv.z) * ex2(r1[0] - b1[0]), bhi(kv.z) * ex2(r1[1] - b1[1]), blo(kv.w) * ex2(r1[2] - b1[2]), bhi(kv.w) * ex2(r1[3] - b1[3])};
            d4 = __builtin_amdgcn_mfma_f32_16x16x32_bf16(pack8f(av), pack8f(bv), d4, 0, 0, 0);
        }
#pragma unroll
        for (int r = 0; r < 4; ++r) *(LAS bf16*)(L + H3_AA + (16 * i + 4 * kq + r) * AP + (16 * j + r16) * 2) = (bf16)f2bf(d4[r]);
    } } }
    }
    __syncthreads();
    const int tn = tid >> 3, part = tid & 7;
    const v4u g0 = *(const v4u*)(Gs + (size_t)(t0 + tn) * HW + h * HKD + 16 * part), g1v = *(const v4u*)(Gs + (size_t)(t0 + tn) * HW + h * HKD + 16 * part + 8);
    f32x4 nwv[4];
#pragma unroll
    for (int i = 0; i < 4; ++i) nwv[i] = *(const f32x4*)(nw + h * HKD + 16 * part + 4 * i);
    f32x16 acc = {0.f, 0.f, 0.f, 0.f, 0.f, 0.f, 0.f, 0.f, 0.f, 0.f, 0.f, 0.f, 0.f, 0.f, 0.f, 0.f};
    { lcp bb = (lcp)L + H3_VV + (8 * hi + q4) * KP + (32 * vt + 16 * g1 + 4 * p4) * 2; lcp aa = (lcp)L + H3_AA + (32 * tt + r32) * AP + (8 * hi) * 2;
#pragma unroll
      for (int ks = 0; ks < 4; ++ks) {
          const bf16x8 af2 = *(const LAS bf16x8*)(aa + 32 * ks);
          const bf16x8 bf = cat8(vtr(bb + 16 * ks * KP), vtr(bb + (16 * ks + 4) * KP));
          acc = __builtin_amdgcn_mfma_f32_32x32x16_bf16(af2, bf, acc, 0, 0, 0);
      } }
    bf16x8 sfb[4][2];
#pragma unroll
    for (int kt2 = 0; kt2 < 4; ++kt2) { const bf16* sp = SU + st_tile(1, h, c, kt2 * 4 + vt) + lane * 16; sfb[kt2][0] = *(const bf16x8*)sp; sfb[kt2][1] = *(const bf16x8*)(sp + 8); }
#pragma unroll
    for (int d = 0; d < 2; ++d)
#pragma unroll
        for (int kt2 = 0; kt2 < 4; ++kt2)
#pragma unroll
            for (int s2 = 0; s2 < 2; ++s2) {
                lcp qp = (lcp)L + H3_QI + d * 64 * QP + (32 * tt + r32) * QP + (32 * kt2 + 16 * s2 + 4 * hi) * 2;
                const u32x2 lo = *(const LAS u32x2*)qp, hh = *(const LAS u32x2*)(qp + 16);
                const v4u av = {lo.x, lo.y, hh.x, hh.y};
                acc = __builtin_amdgcn_mfma_f32_32x32x16_bf16(__builtin_bit_cast(bf16x8, av), d ? sfb[kt2][s2] : sfr[kt2][s2], acc, 0, 0, 0);
            }
    LAS float* ON = (LAS float*)(L + H3_ON);
#pragma unroll
    for (int r = 0; r < 16; ++r) ON[(32 * tt + crow(r, hi)) * PHP + 32 * vt + r32] = acc[r];
    __syncthreads();
    { const int t = tn; float ov[16]; float ss = 0.f;
#pragma unroll
      for (int i = 0; i < 4; ++i) { const f32x4 a = *(const LAS f32x4*)(ON + t * PHP + 16 * part + 4 * i); ov[4 * i] = a[0]; ov[4 * i + 1] = a[1]; ov[4 * i + 2] = a[2]; ov[4 * i + 3] = a[3];
          ss += (a[0] * a[0] + a[1] * a[1]) + (a[2] * a[2] + a[3] * a[3]); }
      ss += __shfl_xor(ss, 1); ss += __shfl_xor(ss, 2); ss += __shfl_xor(ss, 4);
      const float rs = 1.0f / sqrtf(ss * (1.0f / HKD) + 1e-6f);
      const float gg[16] = {blo(g0.x), bhi(g0.x), blo(g0.y), bhi(g0.y), blo(g0.z), bhi(g0.z), blo(g0.w), bhi(g0.w), blo(g1v.x), bhi(g1v.x), blo(g1v.y), bhi(g1v.y), blo(g1v.z), bhi(g1v.z), blo(g1v.w), bhi(g1v.w)};
      float ov2[16];
#pragma unroll
      for (int i = 0; i < 16; ++i) ov2[i] = ov[i] * rs * nwv[i >> 2][i & 3] * gg[i];
      bf16* op = OA + (size_t)(t0 + t) * OAW + h * HKD + 16 * part;
      *(bf16x8*)op = pack8f(ov2); *(bf16x8*)(op + 8) = pack8f(ov2 + 8); }
    __syncthreads();
}
}

struct Args { const float* in[14]; float* out; unsigned char* ws; int ph_lo, ph_hi; unsigned char bucket[400]; };
static_assert(sizeof(Args) == 14 * 8 + 8 + 8 + 8 + 400, "Args has no holes");
enum { IN_X = 0, IN_WIN, IN_LBF, IN_LBB, IN_HNW, IN_RBT, IN_WBH, IN_WBA, IN_WOUT, IN_NMIX, IN_NMLP, IN_WUP, IN_WDOWN, IN_FNW };
constexpr int PH_PRO = 0, PH_PER_LAYER = 8, PH_G1 = 0, PH_H1 = 1, PH_H2 = 2, PH_H3 = 3, PH_GAB = 4, PH_GO = 5, PH_GU = 6, PH_GD = 7, PH_FIN = 1 + DEPTH * PH_PER_LAYER, PH_TOTAL = PH_FIN + 1;

struct P0Tile { const float* src; bf16* dst; const float* ks; int N, K; };
constexpr int I_W1 = (DM / 64) * (NIN / 256), I_WU = (DM / 64) * (DFF / 256), I_WD = (DFF / 64) * (DM / 256), I_WO = (DM / 64) * (DM / 256), I_WA = (HW / 64) * (DM / 256), I_WB = (AOW / 64) * (DM / 256);
constexpr int I_LAYER = I_W1 + I_WU + I_WD + I_WO + I_WA + I_WB;
__device__ __forceinline__ P0Tile p0_decode(const Args& args, unsigned char* ws, int it, int wave, int lane) {
    const int l = it / I_LAYER; int r = it % I_LAYER; unsigned char* wl = ws + WS_W + (size_t)l * WL_STRIDE;
    const float* W; bf16* WT; const float* ks = nullptr; int K, N; const bool isw1 = r < I_W1;
    if (r < I_W1) { W = args.in[IN_WIN] + (size_t)l * DM * NIN; K = DM; N = NIN; WT = (bf16*)(wl + WL_W1); ks = args.in[IN_NMIX] + l * DM; }
    else if ((r -= I_W1) < I_WU) { W = args.in[IN_WUP] + (size_t)l * DM * DFF; K = DM; N = DFF; WT = (bf16*)(wl + WL_WU); ks = args.in[IN_NMLP] + l * DM; }
    else if ((r -= I_WU) < I_WD) { W = args.in[IN_WDOWN] + (size_t)l * DFF * DM; K = DFF; N = DM; WT = (bf16*)(wl + WL_WD); }
    else if ((r -= I_WD) < I_WO) { W = args.in[IN_WOUT] + (size_t)l * DM * DM; K = DM; N = DM; WT = (bf16*)(wl + WL_WO); }
    else if ((r -= I_WO) < I_WA) { W = args.in[IN_WBH] + (size_t)l * HW * DM; K = OAW; N = DM; WT = (bf16*)(wl + WL_WA); }
    else { r -= I_WA; W = args.in[IN_WBA] + (size_t)l * AOW * DM; K = OAW; N = DM; WT = (bf16*)(wl + WL_WA) + HW; }
    const int ntn = N >> 8, kb = r / ntn, nb = r - kb * ntn;
    int rowb = 256 * nb;
    if (isw1 && nb >= 38) { const int isb = nb >= 46 ? 1 : 0, b = nb - (isb ? 46 : 38); rowb = 9728 + 512 * b + 128 * isb + (wave >= 4 ? 128 : 0); }
    P0Tile t; t.src = W + (size_t)(64 * kb + 8 * wave) * N + 256 * nb + 4 * lane; t.dst = WT + (size_t)(rowb + 32 * wave + (lane >> 3)) * K + 64 * kb + 8 * (lane & 7);
    t.ks = ks ? ks + 64 * kb + 8 * wave : nullptr; t.N = N; t.K = K; return t;
}
__device__ __forceinline__ void p0_load(const P0Tile& t, f32x4 (&r)[8]) {
#pragma unroll
    for (int j = 0; j < 8; ++j) r[j] = *(const GAS f32x4*)(t.src + (size_t)j * t.N);
}
__device__ __forceinline__ void p0_to_lds(const P0Tile& t, f32x4 (&r)[8], LAS unsigned char* img, int wave, int lane) {
    if (t.ks) {
#pragma unroll
        for (int j = 0; j < 8; ++j) r[j] = r[j] * t.ks[j]; }
#pragma unroll
    for (int i = 0; i < 4; ++i) { v4u o; o.x = mix::cvtpk(r[0][i], r[1][i]); o.y = mix::cvtpk(r[2][i], r[3][i]); o.z = mix::cvtpk(r[4][i], r[5][i]); o.w = mix::cvtpk(r[6][i], r[7][i]);
        *(LAS v4u*)(img + (4 * lane + i) * 128 + 16 * (wave ^ (lane & 7))) = o; }
}
__device__ __forceinline__ void p0_from_lds(const P0Tile& t, LAS const unsigned char* img, int wave, int lane) {
#pragma unroll
    for (int j = 0; j < 4; ++j) { const int n = 32 * wave + 8 * j + (lane >> 3), ch = lane & 7;
        const v4u o = *(const LAS v4u*)(img + n * 128 + 16 * (ch ^ ((n >> 2) & 7)));
        *(GAS v4u*)(t.dst + (size_t)(8 * j) * t.K) = o; }
}

template <class Map>
__device__ __forceinline__ void p0_run(const Args& args, unsigned char* ws, LAS unsigned char* ring, int wave, int lane, int first, int count, int stride, Map map) {
    f32x4 ra[8]; int q = first, par = 0;
    if (q < count) { P0Tile ta = p0_decode(args, ws, map(q), wave, lane); p0_load(ta, ra);
        for (;;) {
            LAS unsigned char* img = ring + par * 32768;
            p0_to_lds(ta, ra, img, wave, lane);
            const P0Tile tc = ta; const int q1 = q + stride;
            if (q1 < count) { ta = p0_decode(args, ws, map(q1), wave, lane); p0_load(ta, ra); }
            __syncthreads();
            p0_from_lds(tc, img, wave, lane);
            if (q1 >= count) break;
            q = q1; par ^= 1; } }
    __syncthreads();
}
constexpr int P0_ND = 1024;
__device__ __forceinline__ void p0_split(int G, int& nfull, int& nd) { const int nwg = (M / 256) * (NIN / 256), maxt = (nwg + G - 1) / G; nfull = nwg - (maxt - 1) * G; nd = (nfull < G && maxt > 1) ? P0_ND : 0; }

__global__ void __launch_bounds__(NWAVES * 64, 2) skel_fwd(Args args) {
    extern __shared__ __attribute__((aligned(16))) unsigned char lds[];
    LAS unsigned char* const L = (LAS unsigned char*)lds;
    volatile LAS unsigned* MISC = (volatile LAS unsigned*)(L + MISC_OFF);
    const int tid = threadIdx.x, lane = tid & 63, wave = __builtin_amdgcn_readfirstlane(tid >> 6);
    const int G = gridDim.x, bx = blockIdx.x;
    unsigned char* ws = args.ws;
    gu32* ctl = (gu32*)(ws + WS_CTL);
    float* SS = (float*)(ws + WS_SSP);
    for (int u = tid; u < (LDS_BYTES - LDSCTL_OFF) / 4; u += NWAVES * 64) ((LAS unsigned*)(L + LDSCTL_OFF))[u] = 0u;
    __syncthreads();
    XcdBarrier bar = xcd_barrier_post((unsigned*)(ctl + CW_BAR), MISC + 8);
    const int lo = args.ph_lo, hi = args.ph_hi;
#define IN(k) (lo <= (k) && (k) < hi)
#define BOTH(k) (IN(k) && IN((k) + 1))
#define GRID_BAR() xcd_barrier(bar, wave * 64 + lane_now())
    const int gw = bx * NWAVES + wave, NGW = G * NWAVES;

    if (IN(PH_PRO)) {
        { int nfull, nd; p0_split(G, nfull, nd); const int per = I_LAYER - nd;
          p0_run(args, ws, L + RING_OFF, wave, lane, bx, I_LAYER + (DEPTH - 1) * per, G, [=](int q) { if (q < I_LAYER) return q; const int q2 = q - I_LAYER, l = 1 + q2 / per; return l * I_LAYER + (q2 - (l - 1) * per); }); }
        { const float* x = args.in[IN_X]; bf16* XB = (bf16*)(ws + WS_XB);
          for (int m = gw; m < M; m += NGW) {
              const GAS f32x4* xr = (const GAS f32x4*)(x + (size_t)m * DM) + lane; float s = 0.f;
              GAS unsigned long long* o8 = (GAS unsigned long long*)(XB + (size_t)m * DM) + lane;
#pragma unroll
              for (int j = 0; j < 8; ++j) { const f32x4 v = xr[64 * j]; s += (v.x * v.x + v.y * v.y) + (v.z * v.z + v.w * v.w);
                  o8[64 * j] = (unsigned long long)pk2(v.x, v.y) | ((unsigned long long)pk2(v.z, v.w) << 32); }
              s = wave_sum(s); if (lane < 32) SS[(size_t)m * 32 + lane] = (lane == 0) ? s : 0.f; } }
        { float* LB = (float*)(ws + WS_LB);
          for (int i = bx * NWAVES * 64 + tid; i < 2 * HW; i += G * NWAVES * 64) { const int d = i / HW, c = i % HW; const float* lg = args.in[d ? IN_LBB : IN_LBF];
              const float a0 = lg[c], a1 = lg[HW + c], a2 = lg[2 * HW + c], a3 = lg[3 * HW + c]; const float mx = fmaxf(fmaxf(a0, a1), fmaxf(a2, a3));
              const float e0 = expf(a0 - mx), e1 = expf(a1 - mx), e2 = expf(a2 - mx), e3 = expf(a3 - mx), inv = 1.0f / (e0 + e1 + e2 + e3);
              const float p0 = e0 * inv, p1 = e1 * inv, p2 = e2 * inv, p3 = e3 * inv; const float c0 = p0, c1 = c0 + p1, c2 = c1 + p2, c3 = c2 + p3;
              LB[(0 * 2 + d) * HW + c] = c0 - p0; LB[(1 * 2 + d) * HW + c] = c1 - p0; LB[(2 * 2 + d) * HW + c] = c2 - p0; LB[(3 * 2 + d) * HW + c] = c3 - p0; } }
        { float* BI = (float*)(ws + WS_BIAS); const float* rbt = args.in[IN_RBT];
          for (int i = bx * NWAVES * 64 + tid; i < 12 * 192; i += G * NWAVES * 64) { const int hg = i / 192, j = i % 192 - 32, n = hg >> 2;
              BI[i] = (j >= 0 && j < 129) ? rbt[(int)args.bucket[n * 132 + j] * 12 + hg] * 1.4426950408889634f : -1e30f; } }
        if (BOTH(PH_PRO)) GRID_BAR();
    }

    for (int l = 0; l < DEPTH; ++l) {
        const int pb = 1 + l * PH_PER_LAYER;
        unsigned char* wl = ws + WS_W + (size_t)l * WL_STRIDE;
        bf16* XB = (bf16*)(ws + WS_XB);
        if (IN(pb + PH_G1)) {
            pg8::Gemm g{XB, (const bf16*)(wl + WL_W1), M, NIN, DM, DM, DM}; pg8::StaticOrder S; S.init(M, NIN, G, bx, 32);
            pg8::EpiG1 E{ws, SS + (size_t)(2 * l) * M * 32, (const float*)(ws + WS_LB) + l * 2 * HW};
            pg8::gemm_phase<pg8::EpiG1, pg8::StaticOrder, true, true>(L + RING_OFF, g, S, E, wave);
            if (l + 1 < DEPTH) { int nfull, nd; p0_split(G, nfull, nd);
                if (nd > 0 && bx >= nfull) { const int base = (l + 1) * I_LAYER + (I_LAYER - nd); p0_run(args, ws, L + RING_OFF, wave, lane_now(), bx - nfull, nd, G - nfull, [=](int q) { return base + q; }); } }
            if (BOTH(pb + PH_G1)) GRID_BAR();
        }
        if (IN(pb + PH_H1)) {
            const int t2 = wave * 64 + lane_now();
            if (bx < NHH * 128) { mix::H1Pre P; mix::h1_load(bx, t2, (const bf16*)(ws + WS_KF), (const bf16*)(ws + WS_KB), (const bf16*)(ws + WS_LFF), (const bf16*)(ws + WS_LFB), (const bf16*)(ws + WS_VH), P);
              for (int u = bx; u < NHH * 128; u += G)
                mix::h1_unit(u, (LAS char*)L, t2, (const bf16*)(ws + WS_KF), (const bf16*)(ws + WS_KB), (const bf16*)(ws + WS_LFF), (const bf16*)(ws + WS_LFB), (const bf16*)(ws + WS_VH), (bf16*)(ws + WS_SU), (float*)(ws + WS_DD),
                              (u + G < NHH * 128) ? u + G : u, P); }
            if (BOTH(pb + PH_H1)) GRID_BAR();
        }
        if (IN(pb + PH_H2)) {
            const int t2 = wave * 64 + lane_now();
            if (t2 == 0) MISC[16] = 0u;
            __syncthreads();
            if (wave < 2) { for (int gid = bx * 128 + t2; gid < 2 * NHH * 16 * 128; gid += G * 128) mix::h2_scan(gid, (bf16*)(ws + WS_SU), (const float*)(ws + WS_DD), (LAS float*)(L + mix::H2_DL + wave * mix::H2_DL_WAVE), t2 & 63); }
            for (;;) {
                const int ln = lane_now();
                unsigned j = 0; if (ln == 0) j = __hip_atomic_fetch_add((LAS unsigned*)(L + MISC_OFF) + 16, 1u, __ATOMIC_RELAXED, __HIP_MEMORY_SCOPE_WORKGROUP);
                j = (unsigned)__builtin_amdgcn_readfirstlane((int)j); const int per = (3 * 1024 + G - 1) / G; if ((int)j >= per) break;
                const int it = bx * per + (int)j; if (it >= 3 * 1024) break;
                mix::attn_item(it, ln, (LAS char*)L + wave * mix::ATT_WAVE_LDS, (const bf16*)(ws + WS_AQ), (const bf16*)(ws + WS_AK), (const bf16*)(ws + WS_AV), (const float*)(ws + WS_BIAS), (bf16*)(ws + WS_OP), (float*)(ws + WS_LSE)); }
            if (BOTH(pb + PH_H2)) GRID_BAR();
        }
        if (IN(pb + PH_H3)) {
            const int t2 = wave * 64 + lane_now();
            if (bx < NHH * 128) { mix::H3Pre P; mix::h3_lf_load(bx, t2, (const bf16*)(ws + WS_LFF), (const bf16*)(ws + WS_LFB), (const bf16*)(ws + WS_QH), (const bf16*)(ws + WS_VH), P);
              for (int u = bx; u < NHH * 128; u += G)
                mix::h3_unit(u, (LAS char*)L, t2, (const bf16*)(ws + WS_QH), (const bf16*)(ws + WS_KF), (const bf16*)(ws + WS_KB), (const bf16*)(ws + WS_LFF), (const bf16*)(ws + WS_LFB), (const bf16*)(ws + WS_VH),
                             (const bf16*)(ws + WS_GS), (const bf16*)(ws + WS_SU), args.in[IN_HNW] + l * HW, (bf16*)(ws + WS_OA), (u + G < NHH * 128) ? u + G : u, P); }
            mix::attn_combine(bx * NWAVES * 64 + wave * 64 + lane_now(), G * NWAVES * 64, (const bf16*)(ws + WS_OP), (const float*)(ws + WS_LSE), (bf16*)(ws + WS_OA));
            if (BOTH(pb + PH_H3)) GRID_BAR();
        }
        if (IN(pb + PH_GAB)) {
            bf16* OA = (bf16*)(ws + WS_OA);
            { pg8::Gemm g{OA, (const bf16*)(wl + WL_WA), M, DM, OAW, OAW, OAW}; pg8::StaticOrder S; S.init(M, DM, G, bx);
              pg8::EpiGAB E{ws};
              pg8::gemm_phase<pg8::EpiGAB, pg8::StaticOrder, true, true, HW / 64>(L + RING_OFF, g, S, E, wave); }
            if (BOTH(pb + PH_GAB)) GRID_BAR();
        }
        if (IN(pb + PH_GO)) {
            pg8::Gemm g{(const bf16*)(ws + WS_MG), (const bf16*)(wl + WL_WO), M, DM, DM, DM, DM}; pg8::StaticOrder S; S.init(M, DM, G, bx);
            pg8::EpiRes E{XB, SS + (size_t)(2 * l + 1) * M * 32, DM};
            pg8::gemm_phase<pg8::EpiRes, pg8::StaticOrder, true, true>(L + RING_OFF, g, S, E, wave);
            if (BOTH(pb + PH_GO)) GRID_BAR();
        }
        if (IN(pb + PH_GU)) {
            pg8::Gemm g{XB, (const bf16*)(wl + WL_WU), M, DFF, DM, DM, DM}; pg8::StaticOrder S; S.init(M, DFF, G, bx);
            pg8::EpiUp E{SS + (size_t)(2 * l + 1) * M * 32, (bf16*)(ws + WS_UU), DFF};
            pg8::gemm_phase<pg8::EpiUp, pg8::StaticOrder, true, true>(L + RING_OFF, g, S, E, wave);
            if (BOTH(pb + PH_GU)) GRID_BAR();
        }
        if (IN(pb + PH_GD)) {
            pg8::Gemm g{(const bf16*)(ws + WS_UU), (const bf16*)(wl + WL_WD), M, DM, DFF, DFF, DFF}; pg8::StaticOrder S; S.init(M, DM, G, bx);
            pg8::EpiRes E{XB, SS + (size_t)(2 * l + 2) * M * 32, DM};
            pg8::gemm_phase<pg8::EpiRes, pg8::StaticOrder, true, true>(L + RING_OFF, g, S, E, wave);
            if (BOTH(pb + PH_GD)) GRID_BAR();
        }
    }
    if (IN(PH_FIN)) {
        const int lane = (int)__builtin_amdgcn_mbcnt_hi(~0u, __builtin_amdgcn_mbcnt_lo(~0u, 0u));
        const bf16* XBf = (const bf16*)(ws + WS_XB); const float* fw = args.in[IN_FNW];
        for (int m = gw; m < M; m += NGW) {
            const GAS v4u* xr = (const GAS v4u*)(XBf + (size_t)m * DM) + lane; float v[32]; float s = 0.f;
#pragma unroll
            for (int j = 0; j < 4; ++j) { const v4u w = xr[64 * j]; v[8 * j] = mix::blo(w.x); v[8 * j + 1] = mix::bhi(w.x); v[8 * j + 2] = mix::blo(w.y); v[8 * j + 3] = mix::bhi(w.y);
                v[8 * j + 4] = mix::blo(w.z); v[8 * j + 5] = mix::bhi(w.z); v[8 * j + 6] = mix::blo(w.w); v[8 * j + 7] = mix::bhi(w.w); }
#pragma unroll
            for (int i = 0; i < 32; ++i) s += v[i] * v[i];
            const float rs = 1.0f / sqrtf(wave_sum(s) * (1.0f / DM) + pg8::RMS_EPS);
#pragma unroll
            for (int j = 0; j < 4; ++j) { const f32x4 w0 = *(const GAS f32x4*)(fw + 512 * j + 8 * lane), w1 = *(const GAS f32x4*)(fw + 512 * j + 8 * lane + 4);
                GAS f32x4* o = (GAS f32x4*)(args.out + (size_t)m * DM + 512 * j + 8 * lane);
                o[0] = (f32x4){v[8 * j] * rs * w0[0], v[8 * j + 1] * rs * w0[1], v[8 * j + 2] * rs * w0[2], v[8 * j + 3] * rs * w0[3]};
                o[1] = (f32x4){v[8 * j + 4] * rs * w1[0], v[8 * j + 5] * rs * w1[1], v[8 * j + 6] * rs * w1[2], v[8 * j + 7] * rs * w1[3]}; }
        }
    }
#undef IN
#undef BOTH
#undef GRID_BAR
}

static int t5_bucket_host(int rel) {
    const int half = 16, max_exact = 8; int ret = rel > 0 ? half : 0; const int n = rel < 0 ? -rel : rel;
    int large = max_exact + (int)(std::log((double)(n > 1 ? n : 1) / max_exact) / std::log(1024.0 / max_exact) * (half - max_exact));
    if (large > half - 1) large = half - 1;
    return ret + (n < max_exact ? n : large);
}
extern "C" void kernel_launch(void* const* d_in, const int* in_sizes, int n_in, void* d_out, int out_size, void* d_ws, size_t ws_size, hipStream_t stream) {
    static int grid = 0;
    if (grid == 0) {
        if (n_in != 14 || in_sizes[0] != M * DM || out_size != M * DM || ws_size < WS_END) { fprintf(stderr, "kernel_launch: unexpected shapes / workspace (%d inputs, ws %zu, need %zu)\n", n_in, ws_size, (size_t)WS_END); grid = -1; return; }
        int dev = 0, cus = 0;
        if (hipGetDevice(&dev) != hipSuccess || hipDeviceGetAttribute(&cus, hipDeviceAttributeMultiprocessorCount, dev) != hipSuccess) { grid = -1; return; }
        if (hipFuncSetAttribute((const void*)skel_fwd, hipFuncAttributeMaxDynamicSharedMemorySize, LDS_BYTES) != hipSuccess) { grid = -1; return; }
        int per_cu = 0; (void)hipOccupancyMaxActiveBlocksPerMultiprocessor(&per_cu, (const void*)skel_fwd, NWAVES * 64, LDS_BYTES); (void)hipGetLastError();
        grid = cus;
    }
    if (grid < 0) return;
    (void)hipMemsetAsync((char*)d_ws + WS_CTL, 0, CTL_ZERO_BYTES, stream);
    Args a; memset(&a, 0, sizeof(a));
    for (int i = 0; i < 14; ++i) a.in[i] = (const float*)d_in[i];
    a.out = (float*)d_out; a.ws = (unsigned char*)d_ws;
    { const int dils[3] = {1, 4, 16}; for (int n = 0; n < 3; ++n) for (int j = 0; j < 129; ++j) a.bucket[n * 132 + j] = (unsigned char)t5_bucket_host((j - 64) * dils[n]); }
    auto frame = [&](int lo, int hi) { a.ph_lo = lo; a.ph_hi = hi; hipLaunchKernelGGL(skel_fwd, dim3(grid), dim3(NWAVES * 64), LDS_BYTES, stream, a); };
#if defined(MK_LAUNCH_PER_PHASE)
    for (int ph = 0; ph < PH_TOTAL; ++ph) frame(ph, ph + 1);
#else
    frame(0, PH_TOTAL);
#endif
#if defined(PROBE_PHASE)
    for (int r = 0; r < PROBE_REPS; ++r) frame(1 + 3 * PH_PER_LAYER + PROBE_PHASE, 1 + 3 * PH_PER_LAYER + PROBE_PHASE + 1);
#endif
}
```

```cpp
#include <hip/hip_runtime.h>
#include <cstdio>
#include <cstdint>
#include <cstring>
#include <cmath>
constexpr int NWAVES = 8;
constexpr int SEQ = 8192, DM = 2048, DEPTH = 4, HW = 1024, NHH = 8, HKD = 128, AW = 1536, AOW = 512, DFF = 8192, NIN = 13824, OAW = HW + AOW;
constexpr int M = SEQ;
constexpr size_t MiB = 1u << 20;
constexpr size_t WS_CTL = 0, CTL_ZERO_BYTES = 32768;
constexpr size_t WS_LB = 1 * MiB;
constexpr size_t WS_BIAS = WS_LB + 65536;
constexpr size_t WS_W = 2 * MiB;
constexpr size_t WL_W1 = 0, WL_WU = 54 * MiB, WL_WD = 86 * MiB, WL_WO = 118 * MiB, WL_WA = 126 * MiB, WL_WB = 130 * MiB, WL_STRIDE = 132 * MiB;
constexpr size_t WS_XB = WS_W + 4 * WL_STRIDE;
constexpr size_t WS_QH = WS_XB + 32 * MiB;
constexpr size_t WS_KF = WS_QH + 16 * MiB, WS_KB = WS_KF + 16 * MiB, WS_VH = WS_KB + 16 * MiB, WS_GS = WS_VH + 16 * MiB;
constexpr size_t WS_LFF = WS_GS + 16 * MiB, WS_LFB = WS_LFF + 32 * MiB;
constexpr size_t WS_AQ = WS_LFB + 32 * MiB, WS_AK = WS_AQ + 24 * MiB, WS_AV = WS_AK + 24 * MiB;
constexpr size_t WS_GA = WS_AV + 24 * MiB, WS_GB = WS_GA + 32 * MiB;
constexpr size_t WS_OA = WS_GB + 32 * MiB;
constexpr size_t WS_MG = WS_OA + 24 * MiB;
constexpr size_t WS_UU = WS_MG + 32 * MiB;
constexpr size_t WS_SSP = WS_UU + 128 * MiB;
constexpr size_t WS_SU = WS_SSP + 9 * MiB;
constexpr size_t WS_DD = WS_SU + 64 * MiB;
constexpr size_t WS_OP = WS_DD + 1 * MiB;
constexpr size_t WS_LSE = WS_OP + 24 * MiB;
constexpr size_t WS_END = WS_LSE + 1 * MiB;
constexpr int CW_TMO = 0, CW_CODE = 1, CW_BAR = 4096;

namespace pg8 {
#define PG8_LAS __attribute__((address_space(3)))
typedef unsigned short bf16_t;
typedef short bf16x8 __attribute__((ext_vector_type(8)));
typedef float f32x4 __attribute__((ext_vector_type(4)));
typedef unsigned u32x4 __attribute__((ext_vector_type(4)));
constexpr int BM = 256, BK = 64, HALF = 128, HTB = HALF * BK * 2  , STAGE_BYTES = 8 * HTB, NXCD = 8, WGM = 4;

__host__ __device__ __forceinline__ int lds_byte(int r, int c) { const int st = (r >> 4) * 2 + (c >> 5), rr = r & 15, cc = c & 31, ob = rr * 64 + cc * 2; return st * 1024 + (ob ^ (((ob >> 9) & 1) << 5)); }
__host__ __device__ __forceinline__ void stage_rc(int b, int& R, int& C) { const int st = b / 1024, sb = b % 1024, swz = sb ^ (((sb >> 9) & 1) << 5); R = (st >> 1) * 16 + swz / 64; C = (st & 1) * 32 + (swz % 64) / 2; }
__host__ __device__ __forceinline__ int perm32(int rho) { const int n = rho >> 4, i = rho & 15; return 8 * (i >> 2) + 4 * n + (i & 3); }

struct Unit { int pm, pn; };
struct Gemm { const bf16_t* A; const bf16_t* Bt; int M, N, K, lda, ldb; };

struct StaticOrder {
    int nM, nN, nwg, G, c, rot;
    __host__ __device__ void init(int M, int N, int G_, int c_, int rot_ = 0) { nM = M / BM; nN = N / BM; nwg = nM * nN; G = G_; c = c_; rot = rot_; }
    __host__ __device__ bool next(int i, Unit& u) const {
        const long L = (long)i * G + c; if (L >= nwg) return false;
        int wgid = (int)L; { const int q = nwg / NXCD, r = nwg % NXCD, xcd = wgid % NXCD, off = wgid / NXCD; wgid = (xcd < r ? xcd * (q + 1) : r * (q + 1) + (xcd - r) * q) + off; }
        const int nig = WGM * nN, gid = wgid / nig, fm = gid * WGM, gsz = (nM - fm) < WGM ? (nM - fm) : WGM;
        u.pm = fm + ((wgid % nig) % gsz); u.pn = (wgid % nig) / gsz + rot; if (u.pn >= nN) u.pn -= nN; return true;
    }
    __device__ __forceinline__ void a_ready(const Unit&) const {}
    __device__ __forceinline__ void done(const Unit&) const {}
};


typedef float f32x2_t __attribute__((ext_vector_type(2))); typedef __bf16 bf16x2_t __attribute__((ext_vector_type(2)));
__device__ __forceinline__ unsigned cvt_pk_bf16(float lo, float hi) { f32x2_t v = {lo, hi}; bf16x2_t b = __builtin_convertvector(v, bf16x2_t); return __builtin_bit_cast(unsigned, b); }
__device__ __forceinline__ float bf_lo(unsigned w) { return __uint_as_float(w << 16); }
__device__ __forceinline__ float bf_hi(unsigned w) { return __uint_as_float(w & 0xffff0000u); }
__device__ __forceinline__ u32x4 pack8(const float (&v)[8]) { u32x4 w; w.x = cvt_pk_bf16(v[0], v[1]); w.y = cvt_pk_bf16(v[2], v[3]); w.z = cvt_pk_bf16(v[4], v[5]); w.w = cvt_pk_bf16(v[6], v[7]); return w; }
__device__ __forceinline__ void unpack8(u32x4 w, float (&v)[8]) { v[0] = bf_lo(w.x); v[1] = bf_hi(w.x); v[2] = bf_lo(w.y); v[3] = bf_hi(w.y); v[4] = bf_lo(w.z); v[5] = bf_hi(w.z); v[6] = bf_lo(w.w); v[7] = bf_hi(w.w); }
constexpr float ATTN_QSCALE = 0.08838834764831845f * 1.4426950408889634f;
constexpr float RMS_EPS = 1e-6f;
constexpr int RS_REL = 154048;
__device__ __forceinline__ float row_ss_part(const float* P, int row, int fq) {
    const f32x4 a = *(const f32x4*)(P + (size_t)row * 32 + 8 * fq), b = *(const f32x4*)(P + (size_t)row * 32 + 8 * fq + 4);
    return ((a[0] + a[1]) + (a[2] + a[3])) + ((b[0] + b[1]) + (b[2] + b[3]));
}

__device__ __forceinline__ void row_rstd(PG8_LAS float* rsl, const float* rowss, int pm, int wr, int wc, int fr, int fq, float (&rsv)[2][4]) {
    const int wv = wr * 4 + wc; PG8_LAS float* rs = rsl + wv * 128; PG8_LAS int* tg = (PG8_LAS int*)(rsl + 1024) + wv;
    if (*tg != pm) {
#pragma unroll
        for (int ai = 0; ai < 2; ++ai) {
            float p[4];
#pragma unroll
            for (int m = 0; m < 4; ++m) p[m] = row_ss_part(rowss, pm * BM + ai * HALF + wr * 64 + m * 16 + fr, fq);
#pragma unroll
            for (int m = 0; m < 4; ++m) { float t = p[m]; t += __shfl_xor(t, 16); t += __shfl_xor(t, 32); if (fq == 0) rs[ai * 64 + m * 16 + fr] = 1.0f / sqrtf(t * (1.0f / 2048.0f) + RMS_EPS); }
            asm volatile("" ::: "memory");
        }
        if (fq == 0 && fr == 0) *tg = pm;
    }
#pragma unroll
    for (int ai = 0; ai < 2; ++ai)
#pragma unroll
        for (int m = 0; m < 4; ++m) rsv[ai][m] = rs[ai * 64 + m * 16 + fr];
}

struct EpiG1 {
    static constexpr bool PERM = true, AFTER_DRAIN = false, NORM = true;
    unsigned char* ws; const float* rowss; const float* lb;
    __device__ __forceinline__ void operator()(const f32x4 (&acc)[2][2][4][2], const Unit& u, int wr, int wc, int fr, int fq, PG8_LAS unsigned char* lds) const {
        const int pn = u.pn; int kind, ld, c0; size_t dsto, dstfo = 0; int lbo = 0;
        if (pn < 4)       { kind = 0; dsto = WS_QH; ld = 1024; c0 = pn * 256; }
        else if (pn < 8)  { kind = 1; dsto = WS_KF; dstfo = WS_LFF; ld = 1024; c0 = (pn - 4) * 256; }
        else if (pn < 12) { kind = 1; dsto = WS_KB; dstfo = WS_LFB; ld = 1024; c0 = (pn - 8) * 256; lbo = 1024; }
        else if (pn < 16) { kind = 0; dsto = WS_VH; ld = 1024; c0 = (pn - 12) * 256; }
        else if (pn < 20) { kind = 2; dsto = WS_GS; ld = 1024; c0 = (pn - 16) * 256; }
        else if (pn < 26) { kind = 3; dsto = WS_AQ; ld = 1536; c0 = (pn - 20) * 256; }
        else if (pn < 32) { kind = 0; dsto = WS_AK; ld = 1536; c0 = (pn - 26) * 256; }
        else if (pn < 38) { kind = 0; dsto = WS_AV; ld = 1536; c0 = (pn - 32) * 256; }
        else              { kind = 4; dsto = WS_GA; ld = 2048; c0 = (pn - 38) * 128; }
        const int col = c0 + wc * 32 + 8 * fq;
        bf16_t* dst = (bf16_t*)(ws + dsto); bf16_t* dstf = (bf16_t*)(ws + dstfo);
        float rsv[2][4]; row_rstd((PG8_LAS float*)(lds + RS_REL), rowss, u.pm, wr, wc, fr, fq, rsv);
        if (kind == 4) {
            bf16_t* ga = (bf16_t*)(ws + WS_GA); bf16_t* gb = (bf16_t*)(ws + WS_GB);
#pragma unroll
            for (int ai = 0; ai < 2; ++ai)
#pragma unroll
                for (int m = 0; m < 4; ++m) {
                    const int row = u.pm * BM + ai * HALF + wr * 64 + m * 16 + fr; const float rs = rsv[ai][m];
                    float ra[8], sb[8];
                    const float rsn = -1.4426950408889634f * rs;
#pragma unroll
                    for (int i = 0; i < 8; ++i) { const float ta = 1.0f + __builtin_amdgcn_exp2f(acc[ai][0][m][i >> 2][i & 3] * rsn), tb = 1.0f + fminf(__builtin_amdgcn_exp2f(acc[ai][1][m][i >> 2][i & 3] * rsn), 1e20f);
                        sb[i] = __builtin_amdgcn_rcpf(tb); ra[i] = tb * __builtin_amdgcn_rcpf(ta); }
                    const size_t off = (size_t)row * 2048 + col;
                    *(u32x4*)(ga + off) = pack8(ra); *(u32x4*)(gb + off) = pack8(sb);
                }
            return;
        }
        if (kind == 0) body<0>(acc, u, wr, fr, rsv, dst, dstf, ld, col, lbo); else if (kind == 1) body<1>(acc, u, wr, fr, rsv, dst, dstf, ld, col, lbo);
        else if (kind == 2) body<2>(acc, u, wr, fr, rsv, dst, dstf, ld, col, lbo); else body<3>(acc, u, wr, fr, rsv, dst, dstf, ld, col, lbo);
    }
    template <int KIND>
    __device__ __forceinline__ void body(const f32x4 (&acc)[2][2][4][2], const Unit& u, int wr, int fr, const float (&rsv)[2][4], bf16_t* dst, bf16_t* dstf, int ld, int col, int lbo) const {
#pragma unroll
        for (int bj = 0; bj < 2; ++bj) {
            float lbv[8];
#pragma unroll
            for (int i = 0; i < 8; ++i) lbv[i] = (KIND == 1) ? lb[lbo + col + bj * HALF + i] : 0.f;
#pragma unroll
            for (int ai = 0; ai < 2; ++ai)
#pragma unroll
                for (int m = 0; m < 4; ++m) {
                    const int row = u.pm * BM + ai * HALF + wr * 64 + m * 16 + fr;
                    const float rs = (KIND == 3) ? rsv[ai][m] * ATTN_QSCALE : rsv[ai][m];
                    float v[8];
#pragma unroll
                    for (int i = 0; i < 4; ++i) { v[i] = acc[ai][bj][m][0][i] * rs; v[4 + i] = acc[ai][bj][m][1][i] * rs; }
                    const size_t off = (size_t)row * ld + col + bj * HALF;
                    if constexpr (KIND == 1) {
                        float lf[8];
#pragma unroll
                        for (int i = 0; i < 8; ++i) { const float sp = __builtin_amdgcn_rcpf(1.0f + __builtin_amdgcn_exp2f(v[i] * -1.4426950408889634f)); const float l = lbv[i], f = l + (1.0f - l) * sp;
                            lf[i] = __builtin_amdgcn_logf(fmaxf(f, 1e-30f)); }
                        *(u32x4*)(dstf + off) = pack8(lf);
                    } else {
                        if constexpr (KIND == 2) {
#pragma unroll
                            for (int i = 0; i < 8; ++i) v[i] = v[i] * __builtin_amdgcn_rcpf(1.0f + __builtin_amdgcn_exp2f(v[i] * -1.4426950408889634f));
                        }
                        *(u32x4*)(dst + off) = pack8(v);
                    }
                }
        }
    }
};
struct EpiUp {
    static constexpr bool PERM = true, AFTER_DRAIN = false, NORM = true;
    const float* rowss; bf16_t* O; int ldc;
    __device__ __forceinline__ void operator()(const f32x4 (&acc)[2][2][4][2], const Unit& u, int wr, int wc, int fr, int fq, PG8_LAS unsigned char* lds) const {
        const int col = u.pn * BM + wc * 32 + 8 * fq;
        float rsv[2][4]; row_rstd((PG8_LAS float*)(lds + RS_REL), rowss, u.pm, wr, wc, fr, fq, rsv);
#pragma unroll
        for (int ai = 0; ai < 2; ++ai)
#pragma unroll
            for (int m = 0; m < 4; ++m) {
                const int row = u.pm * BM + ai * HALF + wr * 64 + m * 16 + fr;
                const float rs = rsv[ai][m];
#pragma unroll
                for (int bj = 0; bj < 2; ++bj) {
                    float v[8];
#pragma unroll
                    for (int i = 0; i < 4; ++i) { v[i] = fmaxf(acc[ai][bj][m][0][i], 0.f) * rs; v[4 + i] = fmaxf(acc[ai][bj][m][1][i], 0.f) * rs; }
#pragma unroll
                    for (int i = 0; i < 8; ++i) v[i] *= v[i];
                    *(u32x4*)(O + (size_t)row * ldc + col + bj * HALF) = pack8(v);
                }
            }
    }
};
struct EpiRes {
    static constexpr bool PERM = true, AFTER_DRAIN = false, NORM = false;
    bf16_t* xb; float* ss_next; int ldc;
    __device__ __forceinline__ void operator()(const f32x4 (&acc)[2][2][4][2], const Unit& u, int wr, int wc, int fr, int fq, PG8_LAS unsigned char* lds) const {
        const int col = u.pn * BM + wc * 32 + 8 * fq;
#pragma unroll
        for (int ai = 0; ai < 2; ++ai)
#pragma unroll
            for (int m = 0; m < 4; ++m) {
                const int row = u.pm * BM + ai * HALF + wr * 64 + m * 16 + fr;
                float ss = 0.f;
#pragma unroll
                for (int bj = 0; bj < 2; ++bj) {
                    const size_t off = (size_t)row * ldc + col + bj * HALF;
                    float b[8]; unpack8(*(const u32x4*)(xb + off), b);
                    float v[8];
#pragma unroll
                    for (int i = 0; i < 4; ++i) { v[i] = b[i] + acc[ai][bj][m][0][i]; v[4 + i] = b[4 + i] + acc[ai][bj][m][1][i]; }
                    *(u32x4*)(xb + off) = pack8(v);
#pragma unroll
                    for (int i = 0; i < 8; ++i) ss += v[i] * v[i];
                }
                ss += __shfl_xor(ss, 16); ss += __shfl_xor(ss, 32);
                if (fq == 0) ss_next[(size_t)row * 32 + u.pn * 4 + wc] = ss;
            }
    }
};
struct EpiGAB {
    static constexpr bool PERM = true, AFTER_DRAIN = false, NORM = false;
    unsigned char* ws; static constexpr int ldc = 2048;
    __device__ __forceinline__ void mid(f32x4 (&acc)[2][2][4][2], const Unit& u, int wr, int wc, int fr, int fq) const {
        const bf16_t* GA = (const bf16_t*)(ws + WS_GA);
        int col = u.pn * BM + wc * 32 + 8 * fq; asm volatile("" : "+v"(col));
#pragma unroll
        for (int ai = 0; ai < 2; ++ai)
#pragma unroll
            for (int m = 0; m < 4; ++m) {
                const int row = u.pm * BM + ai * HALF + wr * 64 + m * 16 + fr;
#pragma unroll
                for (int bj = 0; bj < 2; ++bj) {
                    const size_t off = (size_t)row * ldc + col + bj * HALF;
                    const u32x4 a = *(const u32x4*)(GA + off);
                    acc[ai][bj][m][0][0] *= bf_lo(a.x); acc[ai][bj][m][0][1] *= bf_hi(a.x); acc[ai][bj][m][0][2] *= bf_lo(a.y); acc[ai][bj][m][0][3] *= bf_hi(a.y);
                    acc[ai][bj][m][1][0] *= bf_lo(a.z); acc[ai][bj][m][1][1] *= bf_hi(a.z); acc[ai][bj][m][1][2] *= bf_lo(a.w); acc[ai][bj][m][1][3] *= bf_hi(a.w);
                }
                asm volatile("" ::: "memory");
            }
    }
    __device__ __forceinline__ void operator()(const f32x4 (&acc)[2][2][4][2], const Unit& u, int wr, int wc, int fr, int fq, PG8_LAS unsigned char* lds) const {
        const bf16_t* GB = (const bf16_t*)(ws + WS_GB); bf16_t* MG = (bf16_t*)(ws + WS_MG);
        const int col = u.pn * BM + wc * 32 + 8 * fq;
#pragma unroll
        for (int ai = 0; ai < 2; ++ai)
#pragma unroll
            for (int m = 0; m < 4; ++m) {
                const int row = u.pm * BM + ai * HALF + wr * 64 + m * 16 + fr;
#pragma unroll
                for (int bj = 0; bj < 2; ++bj) {
                    const size_t off = (size_t)row * ldc + col + bj * HALF;
                    float gb[8]; unpack8(*(const u32x4*)(GB + off), gb);
                    float v[8];
#pragma unroll
                    for (int i = 0; i < 4; ++i) { v[i] = gb[i] * acc[ai][bj][m][0][i]; v[4 + i] = gb[4 + i] * acc[ai][bj][m][1][i]; }
                    *(u32x4*)(MG + off) = pack8(v);
                }
            }
    }
};

template <class Epi, class Sched, bool ALIGN_EPI = false, bool SP2 = false, int MIDT = -1>
__device__ __forceinline__ void gemm_phase(PG8_LAS unsigned char* lds, const Gemm g, const Sched& S, const Epi& E, int wave_) {
    int tid_; { int l_; asm volatile("v_mbcnt_lo_u32_b32 %0, -1, 0\n\tv_mbcnt_hi_u32_b32 %0, -1, %0" : "=v"(l_)); tid_ = wave_ * 64 + l_; }
    const int tid = tid_, wid = __builtin_amdgcn_readfirstlane(tid >> 6), lane = tid & 63, wr = wid >> 2, wc = wid & 3, fr = lane & 15, fq = lane >> 4;
    const int K = g.K, nt = K / BK;
    unsigned voffA[2], voffB[2];
#pragma unroll
    for (int i = 0; i < 2; ++i) { int R, C; stage_rc(tid * 16 + i * 8192, R, C); const int Rb = Epi::PERM ? ((R & ~31) + perm32(R & 31)) : R;
        voffA[i] = (unsigned)(R * g.lda + C) * 2u; voffB[i] = (unsigned)(Rb * g.ldb + C) * 2u; }
    const size_t kstep = (size_t)(BK * 2);
    const size_t hstepA = (size_t)HALF * g.lda * 2, hstepB = (size_t)HALF * g.ldb * 2;
    const size_t tstepA = 2 * hstepA, tstepB = 2 * hstepB;
    if constexpr (Epi::NORM) { if (lane == 0) ((PG8_LAS int*)(lds + RS_REL + 4096))[wid] = -1; }
    const unsigned ldsw = (unsigned)wid * 1024u;
    const int aoff = lds_byte(wr * 64 + fr, fq * 8), boff = lds_byte(wc * 32 + fr, fq * 8);
#define PG8_SA(b, h) (((b) * 2 + (h)) * HTB)
#define PG8_SB(b, h) ((4 + (b) * 2 + (h)) * HTB)
#define PG8_STAGE(bufoff, gbase, voff) do { _Pragma("unroll") for (int _i = 0; _i < 2; ++_i) \
        __builtin_amdgcn_global_load_lds((const unsigned*)((const char*)(gbase) + (voff)[_i]), (PG8_LAS unsigned*)(lds + (bufoff) + ldsw + _i * 8192), 16, 0, 0); } while (0)
#define PG8_LDA(dst, b, h) do { _Pragma("unroll") for (int m = 0; m < 4; ++m) _Pragma("unroll") for (int k = 0; k < 2; ++k) dst[m][k] = *(const PG8_LAS bf16x8*)(lds + PG8_SA(b, h) + aoff + m * 2048 + k * 1024); } while (0)
#define PG8_LDB(dst, b, h) do { _Pragma("unroll") for (int n = 0; n < 2; ++n) _Pragma("unroll") for (int k = 0; k < 2; ++k) dst[n][k] = *(const PG8_LAS bf16x8*)(lds + PG8_SB(b, h) + boff + n * 2048 + k * 1024); } while (0)
#define PG8_MMA(ai, bj, At, Bt) do { __builtin_amdgcn_s_setprio(1); _Pragma("unroll") for (int m = 0; m < 4; ++m) _Pragma("unroll") for (int n = 0; n < 2; ++n) _Pragma("unroll") for (int k = 0; k < 2; ++k) \
        acc[ai][bj][m][n] = __builtin_amdgcn_mfma_f32_16x16x32_bf16(Bt[n][k], At[m][k], acc[ai][bj][m][n], 0, 0, 0); __builtin_amdgcn_s_setprio(0); } while (0)
#define PG8_WAIT_V(n) asm volatile("s_waitcnt vmcnt(" #n ")" ::: "memory")
#define PG8_WAIT_L(n) asm volatile("s_waitcnt lgkmcnt(" #n ")" ::: "memory")
#define PG8_BAR __builtin_amdgcn_s_barrier()
#define PG8_SCHED __builtin_amdgcn_sched_barrier(0)
    Unit cur, nxt; int ui = 0;
    if (!S.next(0, cur)) return;
    f32x4 acc[2][2][4][2];
#pragma unroll
    for (int a = 0; a < 2; ++a)
#pragma unroll
        for (int b = 0; b < 2; ++b)
#pragma unroll
            for (int m = 0; m < 4; ++m)
#pragma unroll
                for (int n = 0; n < 2; ++n) acc[a][b][m][n] = (f32x4){0.f, 0.f, 0.f, 0.f};
    bf16x8 At[4][2], B0[2][2], B1[2][2];
    const char* cA = (const char*)g.A + (size_t)cur.pm * tstepA; const char* cB = (const char*)g.Bt + (size_t)cur.pn * tstepB;
    S.a_ready(cur);
    if constexpr (SP2) {
        PG8_STAGE(PG8_SB(0, 0), cB, voffB); PG8_STAGE(PG8_SB(0, 1), cB + hstepB, voffB); PG8_STAGE(PG8_SA(0, 0), cA, voffA); PG8_STAGE(PG8_SA(0, 1), cA + hstepA, voffA);
        if (wr == 1) PG8_BAR;
        PG8_WAIT_V(2); PG8_BAR;
        PG8_STAGE(PG8_SB(1, 0), cB + kstep, voffB); PG8_STAGE(PG8_SA(1, 0), cA + kstep, voffA); PG8_STAGE(PG8_SB(1, 1), cB + hstepB + kstep, voffB);
        PG8_WAIT_V(6); PG8_BAR;
    } else {
        PG8_STAGE(PG8_SB(0, 0), cB, voffB); PG8_STAGE(PG8_SA(0, 0), cA, voffA); PG8_STAGE(PG8_SB(0, 1), cB + hstepB, voffB); PG8_STAGE(PG8_SA(0, 1), cA + hstepA, voffA);
        if (wr == 1) PG8_BAR;
        PG8_WAIT_V(4); PG8_BAR;
        PG8_STAGE(PG8_SB(1, 0), cB + kstep, voffB); PG8_STAGE(PG8_SA(1, 0), cA + kstep, voffA); PG8_STAGE(PG8_SB(1, 1), cB + hstepB + kstep, voffB);
        PG8_WAIT_V(6); PG8_BAR;
    }
    for (;;) {
        const bool has_next = S.next(ui + 1, nxt);
        const char* nA = has_next ? (const char*)g.A + (size_t)nxt.pm * tstepA : cA; const char* nB = has_next ? (const char*)g.Bt + (size_t)nxt.pn * tstepB : cB;
        for (int t = 0; t < nt; t += 2) {
            const bool last = (t == nt - 2);
            if constexpr (MIDT >= 0) { if (t == MIDT) E.mid(acc, cur, wr, wc, fr, fq); }
            const char* a1 = cA + (size_t)(t + 1) * kstep;
            const char* a2 = last ? nA : cA + (size_t)(t + 2) * kstep; const char* b2 = last ? nB : cB + (size_t)(t + 2) * kstep;
            const char* a3 = a2 + kstep; const char* b3 = b2 + kstep;
            if (last && has_next) S.a_ready(nxt);
            if constexpr (SP2) {
            PG8_LDB(B0, 0, 0); PG8_LDB(B1, 0, 1); PG8_SCHED; PG8_LDA(At, 0, 0); PG8_STAGE(PG8_SA(1, 1), a1 + hstepA, voffA);
            PG8_WAIT_V(8); PG8_WAIT_L(0); PG8_BAR; PG8_MMA(0, 0, At, B0); PG8_MMA(0, 1, At, B1); PG8_BAR; PG8_SCHED;
            PG8_LDA(At, 0, 1); PG8_STAGE(PG8_SB(0, 0), b2, voffB); PG8_STAGE(PG8_SB(0, 1), b2 + hstepB, voffB); PG8_STAGE(PG8_SA(0, 0), a2, voffA);
            PG8_WAIT_V(8); PG8_WAIT_L(0); PG8_BAR; PG8_MMA(1, 0, At, B0); PG8_MMA(1, 1, At, B1); PG8_BAR; PG8_SCHED;
            PG8_LDB(B0, 1, 0); PG8_LDB(B1, 1, 1); PG8_SCHED; PG8_LDA(At, 1, 0); PG8_STAGE(PG8_SA(0, 1), a2 + hstepA, voffA);
            PG8_WAIT_V(8); PG8_WAIT_L(0); PG8_BAR; PG8_MMA(0, 0, At, B0); PG8_MMA(0, 1, At, B1); PG8_BAR; PG8_SCHED;
            PG8_LDA(At, 1, 1); PG8_STAGE(PG8_SB(1, 0), b3, voffB); PG8_STAGE(PG8_SB(1, 1), b3 + hstepB, voffB); PG8_STAGE(PG8_SA(1, 0), a3, voffA);
            PG8_WAIT_V(8); PG8_WAIT_L(0); PG8_BAR; PG8_MMA(1, 0, At, B0); PG8_MMA(1, 1, At, B1); PG8_BAR; PG8_SCHED;
            } else {
            PG8_LDB(B0, 0, 0); PG8_SCHED; PG8_LDA(At, 0, 0); PG8_STAGE(PG8_SA(1, 1), a1 + hstepA, voffA);
            PG8_WAIT_L(8); PG8_BAR; PG8_WAIT_L(0); PG8_MMA(0, 0, At, B0); PG8_BAR; PG8_SCHED;
            PG8_LDB(B1, 0, 1); PG8_STAGE(PG8_SB(0, 0), b2, voffB);
            PG8_BAR; PG8_WAIT_L(0); PG8_MMA(0, 1, At, B1); PG8_BAR;
            PG8_LDA(At, 0, 1); PG8_STAGE(PG8_SA(0, 0), a2, voffA);
            PG8_BAR; PG8_WAIT_L(0); PG8_MMA(1, 0, At, B0); PG8_BAR; PG8_SCHED;
            PG8_STAGE(PG8_SB(0, 1), b2 + hstepB, voffB);
            PG8_WAIT_V(6); PG8_BAR; PG8_MMA(1, 1, At, B1); PG8_BAR;
            PG8_LDB(B0, 1, 0); PG8_SCHED; PG8_LDA(At, 1, 0); PG8_STAGE(PG8_SA(0, 1), a2 + hstepA, voffA);
            PG8_WAIT_L(8); PG8_BAR; PG8_WAIT_L(0); PG8_MMA(0, 0, At, B0); PG8_BAR; PG8_SCHED;
            PG8_LDB(B1, 1, 1); PG8_STAGE(PG8_SB(1, 0), b3, voffB);
            PG8_BAR; PG8_WAIT_L(0); PG8_MMA(0, 1, At, B1); PG8_BAR;
            PG8_LDA(At, 1, 1); PG8_STAGE(PG8_SA(1, 0), a3, voffA);
            PG8_BAR; PG8_WAIT_L(0); PG8_MMA(1, 0, At, B0); PG8_BAR; PG8_SCHED;
            PG8_STAGE(PG8_SB(1, 1), b3 + hstepB, voffB);
            PG8_WAIT_V(6); PG8_BAR; PG8_MMA(1, 1, At, B1); PG8_BAR;
            }
        }
        if constexpr (ALIGN_EPI) { if (wr == 0) PG8_BAR; }
        if constexpr (!Epi::AFTER_DRAIN) { E(acc, cur, wr, wc, fr, fq, lds); S.done(cur); }
        if (!has_next) break;
#pragma unroll
        for (int a = 0; a < 2; ++a)
#pragma unroll
            for (int b = 0; b < 2; ++b)
#pragma unroll
                for (int m = 0; m < 4; ++m)
#pragma unroll
                    for (int n = 0; n < 2; ++n) acc[a][b][m][n] = (f32x4){0.f, 0.f, 0.f, 0.f};
        cur = nxt; cA = nA; cB = nB; ++ui;
        if constexpr (ALIGN_EPI) { if (wr == 1) PG8_BAR; }
    }
    PG8_WAIT_V(0);
    if constexpr (!ALIGN_EPI) { if (wr == 0) PG8_BAR; }
    PG8_BAR;
    if constexpr (Epi::AFTER_DRAIN) { E.fused(acc, cur, wr, wc, fr, fq, lds, wid, lane); S.done(cur); }
#undef PG8_SA
#undef PG8_SB
#undef PG8_STAGE
#undef PG8_LDA
#undef PG8_LDB
#undef PG8_MMA
#undef PG8_WAIT_V
#undef PG8_WAIT_L
#undef PG8_BAR
#undef PG8_SCHED
}
}

constexpr int RING_OFF = 0, RING_BYTES = 131072;
constexpr int MIX_LDS_BYTES = 153600;
constexpr int LDSCTL_OFF = MIX_LDS_BYTES, MISC_OFF = LDSCTL_OFF + 320;
constexpr int RS_OFF = MISC_OFF + 128;
constexpr int LDS_BYTES = 159744;
static_assert(RS_OFF + 4096 + 32 <= LDS_BYTES && RS_OFF == RING_OFF + pg8::RS_REL, "LDS map");

#define GAS __attribute__((address_space(1)))
#define LAS __attribute__((address_space(3)))
typedef unsigned short bf16;
typedef unsigned v4u __attribute__((ext_vector_type(4)));
typedef float f32x4 __attribute__((ext_vector_type(4)));
typedef short bf16x8 __attribute__((ext_vector_type(8)));
typedef GAS unsigned gu32;
#define RLX_AGENT __ATOMIC_RELAXED, __HIP_MEMORY_SCOPE_AGENT
#define LDS_WAIT() asm volatile("s_waitcnt lgkmcnt(0)" ::: "memory")
#define VM_WAIT() asm volatile("s_waitcnt vmcnt(0)" ::: "memory")
typedef float f32x2_fr __attribute__((ext_vector_type(2))); typedef __bf16 bf16x2_fr __attribute__((ext_vector_type(2)));
__device__ __forceinline__ unsigned pk2(float lo, float hi) { f32x2_fr v = {lo, hi}; return __builtin_bit_cast(unsigned, __builtin_convertvector(v, bf16x2_fr)); }
__device__ __forceinline__ unsigned f2bf(float f) { return pk2(f, f) & 0xffffu; }
__device__ __forceinline__ float bf2f(bf16 b) { return __uint_as_float((unsigned)b << 16); }
__device__ __forceinline__ int lane_now() { int l; asm volatile("v_mbcnt_lo_u32_b32 %0, -1, 0\n\tv_mbcnt_hi_u32_b32 %0, -1, %0" : "=v"(l)); return l; }
__device__ __forceinline__ float wave_sum(float v) {
#pragma unroll
    for (int o = 1; o < 64; o <<= 1) v += __shfl_xor(v, o);
    return v;
}
__device__ __forceinline__ float wave_max(float v) {
#pragma unroll
    for (int o = 1; o < 64; o <<= 1) v = fmaxf(v, __shfl_xor(v, o));
    return v;
}

#define XB_TMO      128
#define XB_XCNT(j)  (256  + 64 * (j))
#define XB_XSUB(j)  (1280 + 64 * (j))
#define XB_XGEN(j)  (2304 + 64 * (j))
#define XB_TOP      3328
#define XB_TOPGEN   3392
#define XCD_BAR_WORDS 3456
#define XB_SPIN_CAP (1u << 22)

__device__ __forceinline__ unsigned xb_ld(unsigned* p)              { return __hip_atomic_load(p, __ATOMIC_RELAXED, __HIP_MEMORY_SCOPE_AGENT); }
__device__ __forceinline__ unsigned xb_add(unsigned* p, unsigned v) { return __hip_atomic_fetch_add(p, v, __ATOMIC_RELAXED, __HIP_MEMORY_SCOPE_AGENT); }
__device__ __forceinline__ unsigned xb_xcc_id() { return (unsigned)__builtin_amdgcn_s_getreg((3 << 11) | 20) & 0xFu; }
#define XB_SPIN(cond, bar) do { unsigned _sp = 0; while (cond) { __builtin_amdgcn_s_sleep(1); \
    if ((++_sp & 255u) == 0u) { if (xb_ld(&(bar)[XB_TMO])) break; if (_sp > XB_SPIN_CAP) { atomicAdd(&(bar)[XB_TMO], 1u); break; } } } } while (0)

struct XcdBarrier {
    unsigned* bar; unsigned x;
    volatile LAS unsigned* st;
};

__device__ __forceinline__ XcdBarrier xcd_barrier_post(unsigned* bar, volatile LAS unsigned* st) {
    XcdBarrier b; b.bar = bar; b.x = xb_xcc_id(); b.st = st;
    if (threadIdx.x == 0) (void)xb_add(&bar[XB_XCNT(b.x)], 1u);
    return b;
}
__device__ __forceinline__ void xcd_barrier_complete(unsigned* bar, unsigned x, unsigned& nloc, unsigned& nx) {
    const unsigned G = gridDim.x * gridDim.y * gridDim.z;
    unsigned sum, cnt, mine, sp = 0u;
    for (;;) {
        sum = 0u; cnt = 0u; mine = 0u;
#pragma unroll
        for (unsigned j = 0; j < 16; ++j) { const unsigned c = xb_ld(&bar[XB_XCNT(j)]); sum += c; cnt += (c > 0u) ? 1u : 0u; mine = (j == x) ? c : mine; }
        if (sum == G) break;
        __builtin_amdgcn_s_sleep(1);
        if ((++sp & 255u) == 0u) { if (xb_ld(&bar[XB_TMO])) break; if (sp > XB_SPIN_CAP) { atomicAdd(&bar[XB_TMO], 1u); break; } }
    }
    nloc = mine > 0u ? mine : 1u; nx = cnt > 0u ? cnt : 1u;
}

__device__ __forceinline__ void xcd_barrier(const XcdBarrier& b, int tid) {
    asm volatile("s_waitcnt vmcnt(0)" ::: "memory");
    __syncthreads();
    if (tid == 0) {
        unsigned* bar = b.bar; asm volatile("" : "+s"(bar));
        __builtin_amdgcn_s_waitcnt(0);
        unsigned bx_ = b.x; asm volatile("" : "+s"(bx_));
        unsigned nloc = b.st[0], nx = b.st[1];
        if (nloc == 0u) { xcd_barrier_complete(bar, bx_, nloc, nx); b.st[0] = nloc; b.st[1] = nx; }
        const unsigned old = xb_add(&bar[XB_XSUB(bx_)], 1u);
        const unsigned gen = old / nloc;
        if (old + 1u == (gen + 1u) * nloc) {
            __builtin_amdgcn_fence(__ATOMIC_RELEASE, "agent");
            asm volatile("s_waitcnt vmcnt(0)" ::: "memory");
            const unsigned og = xb_add(&bar[XB_TOP], 1u);
            const unsigned tg = og / nx;
            if (og + 1u == (tg + 1u) * nx) xb_add(&bar[XB_TOPGEN], 1u);
            else XB_SPIN(xb_ld(&bar[XB_TOPGEN]) == tg, bar);
            __builtin_amdgcn_fence(__ATOMIC_ACQUIRE, "agent");
            xb_add(&bar[XB_XGEN(bx_)], 1u);
            asm volatile("s_waitcnt vmcnt(0)" ::: "memory");
        } else {
            XB_SPIN(xb_ld(&bar[XB_XGEN(bx_)]) == gen, bar);
            __builtin_amdgcn_fence(__ATOMIC_ACQUIRE, "agent");
            asm volatile("s_waitcnt vmcnt(0)" ::: "memory");
        }
    }
    __syncthreads();
}

namespace mix {
typedef float f32x16 __attribute__((ext_vector_type(16)));
typedef short s16x4 __attribute__((ext_vector_type(4)));
typedef short v4i16_t __attribute__((ext_vector_type(4)));
typedef unsigned u32x2 __attribute__((ext_vector_type(2)));
typedef LAS const char* lcp;
__device__ __forceinline__ int crow(int r, int hi) { return (r & 3) + 8 * (r >> 2) + 4 * hi; }
__device__ __forceinline__ s16x4 vtr(lcp p) { return __builtin_bit_cast(s16x4, __builtin_amdgcn_ds_read_tr16_b64_v4i16((LAS v4i16_t*)p)); }
__device__ __forceinline__ bf16x8 cat8(s16x4 lo, s16x4 hi) { return (bf16x8){lo[0], lo[1], lo[2], lo[3], hi[0], hi[1], hi[2], hi[3]}; }
typedef float f32x2_t __attribute__((ext_vector_type(2))); typedef __bf16 bf16x2_t __attribute__((ext_vector_type(2)));
__device__ __forceinline__ unsigned cvtpk(float lo, float hi) { f32x2_t v = {lo, hi}; bf16x2_t b = __builtin_convertvector(v, bf16x2_t); return __builtin_bit_cast(unsigned, b); }
__device__ __forceinline__ bf16x8 pack8f(const float* v) { v4u w; w.x = cvtpk(v[0], v[1]); w.y = cvtpk(v[2], v[3]); w.z = cvtpk(v[4], v[5]); w.w = cvtpk(v[6], v[7]); return __builtin_bit_cast(bf16x8, w); }
__device__ __forceinline__ float blo(unsigned w) { return __uint_as_float(w << 16); }
__device__ __forceinline__ float bhi(unsigned w) { return __uint_as_float(w & 0xffff0000u); }
__device__ __forceinline__ float ex2(float x) { return __builtin_amdgcn_exp2f(x); }

constexpr int VP = 320;
constexpr int ATT_LUT = 32 * VP, ATT_WAVE_LDS = 32 * VP + 768;
__device__ __forceinline__ void attn_item(int it, int lane_, LAS char* vbuf, const bf16* AQ, const bf16* AK, const bf16* AV, const float* BI, bf16* OP, float* LSE) {
    const int n = it >> 10, rem = it & 1023, g = rem >> 8, blk = rem & 255, dsh = 2 * n, dil = 1 << dsh, mb = blk & ((256 >> dsh) - 1), c = blk >> (8 - dsh), Lsub = SEQ >> dsh, m0 = mb * 32, hd = 4 * n + g;
    int lane = lane_; asm volatile("" : "+v"(lane));
    const int r32 = lane & 31, hi = lane >> 5;
    LAS float* lut = (LAS float*)(vbuf + ATT_LUT);
#pragma unroll
    for (int i = 0; i < 3; ++i) lut[lane + 64 * i] = BI[hd * 192 + lane + 64 * i];
    constexpr int KPA = 272;
    bf16x8 qf[8]; v4u kst[2][8];
#define ATT_KLOAD(buf, kt) do { _Pragma("unroll") for (int i = 0; i < 8; ++i) { int km_ = m0 - 64 + 32 * (kt) + i * 4 + (lane >> 4); km_ = km_ < 0 ? 0 : (km_ >= Lsub ? Lsub - 1 : km_); \
        kst[buf][i] = *(const v4u*)(AK + (size_t)(km_ * dil + c) * AW + hd * 128 + 8 * (lane & 15)); } } while (0)
#define ATT_VLOAD(buf, kt) do { _Pragma("unroll") for (int i = 0; i < 8; ++i) { int km_ = m0 - 64 + 32 * (kt) + i * 4 + (lane >> 4); km_ = km_ < 0 ? 0 : (km_ >= Lsub ? Lsub - 1 : km_); \
        vv[buf][i] = *(const v4u*)(AV + (size_t)(km_ * dil + c) * AW + hd * 128 + 8 * (lane & 15)); } } while (0)
    { v4u qs[8];
#pragma unroll
      for (int i = 0; i < 8; ++i) qs[i] = *(const v4u*)(AQ + (size_t)((m0 + i * 4 + (lane >> 4)) * dil + c) * AW + hd * 128 + 8 * (lane & 15));
      ATT_KLOAD(0, 0); ATT_KLOAD(1, 1);
#pragma unroll
      for (int i = 0; i < 8; ++i) *(LAS v4u*)(vbuf + (i * 4 + (lane >> 4)) * KPA + (lane & 15) * 16) = qs[i];
      asm volatile("s_waitcnt lgkmcnt(0)" ::: "memory");
#pragma unroll
      for (int d0 = 0; d0 < 8; ++d0) qf[d0] = *(const LAS bf16x8*)(vbuf + r32 * KPA + 32 * d0 + 16 * hi); }
    f32x16 sT[5];
#pragma unroll
    for (int kt = 0; kt < 5; ++kt) {
        asm volatile("s_waitcnt lgkmcnt(0)" ::: "memory");
#pragma unroll
        for (int i = 0; i < 8; ++i) *(LAS v4u*)(vbuf + (i * 4 + (lane >> 4)) * KPA + (lane & 15) * 16) = kst[kt & 1][i];
        if (kt < 3) ATT_KLOAD(kt & 1, kt + 2);
        asm volatile("s_waitcnt lgkmcnt(0)" ::: "memory");
        bf16x8 kfr[8];
#pragma unroll
        for (int d0 = 0; d0 < 8; ++d0) kfr[d0] = *(const LAS bf16x8*)(vbuf + r32 * KPA + 32 * d0 + 16 * hi);
        f32x16 acc = {0.f, 0.f, 0.f, 0.f, 0.f, 0.f, 0.f, 0.f, 0.f, 0.f, 0.f, 0.f, 0.f, 0.f, 0.f, 0.f};
#pragma unroll
        for (int d0 = 0; d0 < 8; ++d0) acc = __builtin_amdgcn_mfma_f32_32x32x16_bf16(kfr[d0], qf[d0], acc, 0, 0, 0);
        sT[kt] = acc;
    }
    v4u vv[2][8];
    ATT_VLOAD(0, 0); ATT_VLOAD(1, 1);
    const LAS float* bl = lut + (32 + 4 * hi - r32);
    const int klo = 64 - m0, khi = Lsub + 64 - m0;
#pragma unroll
    for (int kt = 0; kt < 5; ++kt)
#pragma unroll
        for (int r = 0; r < 16; ++r) sT[kt][r] += bl[32 * kt + (r & 3) + 8 * (r >> 2)];
    if (klo > 0 || khi < 160) {
#pragma unroll
        for (int kt = 0; kt < 5; ++kt)
#pragma unroll
            for (int r = 0; r < 16; ++r) { const int kk = 32 * kt + (r & 3) + 8 * (r >> 2) + 4 * hi; sT[kt][r] = ((kk >= klo) && (kk < khi)) ? sT[kt][r] : -1e30f; }
    }
    float mx = -1e30f;
#pragma unroll
    for (int kt = 0; kt < 5; ++kt)
#pragma unroll
        for (int r = 0; r < 16; ++r) mx = fmaxf(mx, sT[kt][r]);
    mx = fmaxf(mx, __shfl_xor(mx, 32));
    float sum = 0.f;
#pragma unroll
    for (int kt = 0; kt < 5; ++kt)
#pragma unroll
        for (int r = 0; r < 16; ++r) { const float p = ex2(sT[kt][r] - mx); sT[kt][r] = p; sum += p; }
    sum += __shfl_xor(sum, 32);
    bf16x8 pa[5][2];
#pragma unroll
    for (int kt = 0; kt < 5; ++kt)
#pragma unroll
        for (int s16 = 0; s16 < 2; ++s16) { float pv[8];
#pragma unroll
            for (int j = 0; j < 8; ++j) pv[j] = sT[kt][8 * s16 + j];
            pa[kt][s16] = pack8f(pv); }
    f32x16 o[4];
#pragma unroll
    for (int db = 0; db < 4; ++db) o[db] = (f32x16){0.f, 0.f, 0.f, 0.f, 0.f, 0.f, 0.f, 0.f, 0.f, 0.f, 0.f, 0.f, 0.f, 0.f, 0.f, 0.f};
    const int q4 = (lane & 15) >> 2, p4 = lane & 3, g1 = (lane >> 4) & 1;
    lcp vrd = (lcp)vbuf + (4 * hi + q4) * VP + (16 * g1 + 4 * p4) * 2;
#pragma unroll
    for (int kt = 0; kt < 5; ++kt) {
        asm volatile("s_waitcnt lgkmcnt(0)" ::: "memory");
#pragma unroll
        for (int i = 0; i < 8; ++i) *(LAS v4u*)(vbuf + (i * 4 + (lane >> 4)) * VP + (lane & 15) * 16) = vv[kt & 1][i];
        if (kt < 3) ATT_VLOAD(kt & 1, kt + 2);
        asm volatile("s_waitcnt lgkmcnt(0)" ::: "memory");
#pragma unroll
        for (int s16 = 0; s16 < 2; ++s16)
#pragma unroll
            for (int db = 0; db < 4; ++db) {
                const s16x4 lo = vtr(vrd + (16 * s16) * VP + 64 * db), hh = vtr(vrd + (16 * s16 + 8) * VP + 64 * db);
                o[db] = __builtin_amdgcn_mfma_f32_32x32x16_bf16(pa[kt][s16], cat8(lo, hh), o[db], 0, 0, 0);
            }
    }
#undef ATT_KLOAD
#undef ATT_VLOAD
    const float linv = 1.0f / sum;
#pragma unroll
    for (int r = 0; r < 16; ++r) {
        const int qr = crow(r, hi); const float li = __shfl(linv, qr);
        bf16* op = OP + ((size_t)n * SEQ + (size_t)((m0 + qr) * dil + c)) * AOW + g * 128 + r32;
#pragma unroll
        for (int db = 0; db < 4; ++db) op[32 * db] = (bf16)f2bf(o[db][r] * li);
    }
    if (hi == 0) LSE[((size_t)n * SEQ + (size_t)((m0 + r32) * dil + c)) * 4 + g] = mx + __builtin_amdgcn_logf(sum);
}
__device__ __forceinline__ void attn_combine(int gtid, int nthreads, const bf16* OP, const float* LSE, bf16* OA) {
    for (int idx = gtid; idx < SEQ * (AOW / 8); idx += nthreads) {
        const int p = idx >> 6, c8 = idx & 63, g = c8 >> 4;
        const float l0 = LSE[((size_t)0 * SEQ + p) * 4 + g], l1 = LSE[((size_t)1 * SEQ + p) * 4 + g], l2 = LSE[((size_t)2 * SEQ + p) * 4 + g];
        const float ml = fmaxf(l0, fmaxf(l1, l2)); float w0 = ex2(l0 - ml), w1 = ex2(l1 - ml), w2 = ex2(l2 - ml); const float wi = 1.0f / (w0 + w1 + w2); w0 *= wi; w1 *= wi; w2 *= wi;
        const v4u a = *(const v4u*)(OP + ((size_t)0 * SEQ + p) * AOW + c8 * 8), b = *(const v4u*)(OP + ((size_t)1 * SEQ + p) * AOW + c8 * 8), cc = *(const v4u*)(OP + ((size_t)2 * SEQ + p) * AOW + c8 * 8);
        v4u o;
        o.x = cvtpk(w0 * blo(a.x) + w1 * blo(b.x) + w2 * blo(cc.x), w0 * bhi(a.x) + w1 * bhi(b.x) + w2 * bhi(cc.x));
        o.y = cvtpk(w0 * blo(a.y) + w1 * blo(b.y) + w2 * blo(cc.y), w0 * bhi(a.y) + w1 * bhi(b.y) + w2 * bhi(cc.y));
        o.z = cvtpk(w0 * blo(a.z) + w1 * blo(b.z) + w2 * blo(cc.z), w0 * bhi(a.z) + w1 * bhi(b.z) + w2 * bhi(cc.z));
        o.w = cvtpk(w0 * blo(a.w) + w1 * blo(b.w) + w2 * blo(cc.w), w0 * bhi(a.w) + w1 * bhi(b.w) + w2 * bhi(cc.w));
        *(v4u*)(OA + (size_t)p * OAW + HW + c8 * 8) = o;
    }
}

constexpr int KP = 320;
constexpr int H1_KHF = 0, H1_KHB = 64 * KP, H1_VV = 2 * 64 * KP, H1_TOT = 3 * 64 * KP;
__device__ __forceinline__ size_t st_tile(int d, int h, int c, int tile) { return ((((size_t)(d * NHH + h)) * 128 + c) * 16 + tile) * 1024; }
constexpr int H1_LFF = H1_TOT + 4096, H1_LFB = H1_LFF + 64 * 132 * 4, H1_END = H1_LFB + 64 * 132 * 4;
static_assert(H1_END <= MIX_LDS_BYTES, "H1 LDS map");
__device__ __forceinline__ unsigned key2(unsigned w) { return cvtpk(1.0f - ex2(blo(w)), 1.0f - ex2(bhi(w))); }
__device__ __forceinline__ v4u keys_of(v4u w) { v4u o; o.x = key2(w.x); o.y = key2(w.y); o.z = key2(w.z); o.w = key2(w.w); return o; }
struct H1Pre { v4u lf[4]; v4u kv[2]; };
__device__ __forceinline__ void h1_load(int u, int tid, const bf16* Kf, const bf16* Kb, const bf16* LFf, const bf16* LFb, const bf16* Vh, H1Pre& P) {
    const int h = u & 7, c = u >> 3, t0 = c * 64;
#pragma unroll
    for (int i = 0; i < 2; ++i) { const int idx = tid + 512 * i, row = idx >> 4, c16 = idx & 15; const size_t go = (size_t)(t0 + row) * HW + h * HKD + 8 * c16;
        P.lf[i] = *(const v4u*)(LFf + go); P.lf[2 + i] = *(const v4u*)(LFb + go);
        P.kv[i] = *(const v4u*)(Vh + go); }
}
__device__ __forceinline__ void h1_unit(int u, LAS char* L, int tid, const bf16* Kf, const bf16* Kb, const bf16* LFf, const bf16* LFb, const bf16* Vh, bf16* SU, float* DD, int un, H1Pre& P) {
    const int h = u & 7, c = u >> 3, lane = tid & 63, w = __builtin_amdgcn_readfirstlane(tid >> 6), k = lane + 64 * (w & 1), tq = w >> 1;
    LAS float* TOT = (LAS float*)(L + H1_TOT); LAS float* LFF = (LAS float*)(L + H1_LFF); LAS float* LFB = (LAS float*)(L + H1_LFB);
#pragma unroll
    for (int i = 0; i < 2; ++i) { const int idx = tid + 512 * i, row = idx >> 4, c16 = idx & 15; const v4u a = P.lf[i], b = P.lf[2 + i];
        *(LAS f32x4*)(LFF + row * 132 + 8 * c16) = (f32x4){blo(a.x), bhi(a.x), blo(a.y), bhi(a.y)}; *(LAS f32x4*)(LFF + row * 132 + 8 * c16 + 4) = (f32x4){blo(a.z), bhi(a.z), blo(a.w), bhi(a.w)};
        *(LAS f32x4*)(LFB + row * 132 + 8 * c16) = (f32x4){blo(b.x), bhi(b.x), blo(b.y), bhi(b.y)}; *(LAS f32x4*)(LFB + row * 132 + 8 * c16 + 4) = (f32x4){blo(b.z), bhi(b.z), blo(b.w), bhi(b.w)};
        *(LAS v4u*)(L + H1_VV + row * KP + c16 * 16) = P.kv[i]; }
    h1_load(un, tid, Kf, Kb, LFf, LFb, Vh, P);
    __syncthreads();
    float pf[16], pb[16];
    { float sa = 0.f, sb = 0.f;
#pragma unroll
      for (int i = 0; i < 16; ++i) { sa += LFF[(16 * tq + i) * 132 + k]; pf[i] = sa; sb += LFB[(16 * tq + i) * 132 + k]; pb[i] = sb; } }
    TOT[(0 * 4 + tq) * 128 + k] = pf[15]; TOT[(1 * 4 + tq) * 128 + k] = pb[15];
    __syncthreads();
    float sufF = 0.f, preB = 0.f, totF = 0.f, totB = 0.f;
#pragma unroll
    for (int q = 0; q < 4; ++q) { const float tf = TOT[(0 * 4 + q) * 128 + k], tb = TOT[(1 * 4 + q) * 128 + k]; totF += tf; totB += tb; if (q > tq) sufF += tf; if (q < tq) preB += tb; }
#pragma unroll
    for (int i = 0; i < 16; ++i) {
        const float ef = sufF + (pf[15] - pf[i]), eb = preB + (i ? pb[i - 1] : 0.f);
        const float lff = pf[i] - (i ? pf[i - 1] : 0.f), lfb = pb[i] - (i ? pb[i - 1] : 0.f);
        LAS bf16* pkf = (LAS bf16*)(L + H1_KHF + (16 * tq + i) * KP + k * 2); LAS bf16* pkb = (LAS bf16*)(L + H1_KHB + (16 * tq + i) * KP + k * 2);
        *pkf = (bf16)f2bf((1.0f - ex2(lff)) * ex2(ef)); *pkb = (bf16)f2bf((1.0f - ex2(lfb)) * ex2(eb));
    }
    if (tq == 0) { DD[((size_t)(0 * NHH + h) * 128 + c) * 128 + k] = ex2(totF); DD[((size_t)(1 * NHH + h) * 128 + c) * 128 + k] = ex2(totB); }
    __syncthreads();
    const int hi = lane >> 5, q4 = (lane & 15) >> 2, p4 = lane & 3, g1 = (lane >> 4) & 1, kt = w & 3, vh = w >> 2;
#pragma unroll
    for (int d = 0; d < 2; ++d) {
        lcp ab = (lcp)L + (d ? H1_KHB : H1_KHF) + (8 * hi + q4) * KP + (32 * kt + 16 * g1 + 4 * p4) * 2;
        lcp bb = (lcp)L + H1_VV + (8 * hi + q4) * KP + (64 * vh + 16 * g1 + 4 * p4) * 2;
        f32x16 acc0 = {0.f, 0.f, 0.f, 0.f, 0.f, 0.f, 0.f, 0.f, 0.f, 0.f, 0.f, 0.f, 0.f, 0.f, 0.f, 0.f}, acc1 = acc0;
#pragma unroll
        for (int st = 0; st < 4; ++st) {
            const bf16x8 af = cat8(vtr(ab + 16 * st * KP), vtr(ab + (16 * st + 4) * KP));
            const bf16x8 b0 = cat8(vtr(bb + 16 * st * KP), vtr(bb + (16 * st + 4) * KP));
            const bf16x8 b1 = cat8(vtr(bb + 16 * st * KP + 64), vtr(bb + (16 * st + 4) * KP + 64));
            acc0 = __builtin_amdgcn_mfma_f32_32x32x16_bf16(af, b0, acc0, 0, 0, 0);
            acc1 = __builtin_amdgcn_mfma_f32_32x32x16_bf16(af, b1, acc1, 0, 0, 0);
        }
        float t[16];
#pragma unroll
        for (int r = 0; r < 16; ++r) t[r] = acc0[r];
        bf16* o0 = SU + st_tile(d, h, c, kt * 4 + 2 * vh) + lane * 16;
        *(bf16x8*)o0 = pack8f(t); *(bf16x8*)(o0 + 8) = pack8f(t + 8);
#pragma unroll
        for (int r = 0; r < 16; ++r) t[r] = acc1[r];
        bf16* o1 = SU + st_tile(d, h, c, kt * 4 + 2 * vh + 1) + lane * 16;
        *(bf16x8*)o1 = pack8f(t); *(bf16x8*)(o1 + 8) = pack8f(t + 8);
    }
    __syncthreads();
}
constexpr int H2_DL = 90112, H2_DL_WAVE = 16384;
static_assert(H2_DL >= 8 * ATT_WAVE_LDS && H2_DL + 2 * H2_DL_WAVE <= MIX_LDS_BYTES, "H2 LDS map");
__device__ __forceinline__ void h2_scan(int gid, bf16* SU, const float* DD, LAS float* dl, int l64) {
    const int e8 = gid & 127, tile = (gid >> 7) & 15, dh = gid >> 11, d = dh >> 3, lane = e8 >> 1, r0 = (e8 & 1) * 8, kt = tile >> 2, k0 = crow(r0, lane >> 5);
    bf16* base = SU + ((size_t)dh * 128 * 16 + tile) * 1024 + e8 * 8; const float* dsrc = DD + (size_t)dh * 128 * 128 + kt * 32;
#pragma unroll
    for (int b = 0; b < 2; ++b) { f32x4 t[8];
#pragma unroll
        for (int i = 0; i < 8; ++i) { const int idx = l64 + 64 * (8 * b + i); t[i] = *(const f32x4*)(dsrc + (size_t)(idx >> 3) * 128 + 4 * (idx & 7)); }
#pragma unroll
        for (int i = 0; i < 8; ++i) { const int idx = l64 + 64 * (8 * b + i); *(LAS f32x4*)(dl + idx * 4) = t[i]; } }
    asm volatile("s_waitcnt lgkmcnt(0)" ::: "memory");
    const LAS float* dq = dl + k0;
    float s[8] = {0.f, 0.f, 0.f, 0.f, 0.f, 0.f, 0.f, 0.f};
    v4u ua[8], ub[8];
#define H2_LOAD(U, sb) _Pragma("unroll") for (int j = 0; j < 8; ++j) { const int c = d ? 127 - ((sb) + j) : (sb) + j; U[j] = *(const v4u*)(base + (size_t)c * 16 * 1024); }
#define H2_STEP(U, sb) _Pragma("unroll") for (int j = 0; j < 8; ++j) { const int c = d ? 127 - ((sb) + j) : (sb) + j; \
        v4u o; o.x = cvtpk(s[0], s[1]); o.y = cvtpk(s[2], s[3]); o.z = cvtpk(s[4], s[5]); o.w = cvtpk(s[6], s[7]); *(v4u*)(base + (size_t)c * 16 * 1024) = o; \
        const f32x4 d0 = *(const LAS f32x4*)(dq + c * 32), d1 = *(const LAS f32x4*)(dq + c * 32 + 8); \
        s[0] = d0[0] * s[0] + blo(U[j].x); s[1] = d0[1] * s[1] + bhi(U[j].x); s[2] = d0[2] * s[2] + blo(U[j].y); s[3] = d0[3] * s[3] + bhi(U[j].y); \
        s[4] = d1[0] * s[4] + blo(U[j].z); s[5] = d1[1] * s[5] + bhi(U[j].z); s[6] = d1[2] * s[6] + blo(U[j].w); s[7] = d1[3] * s[7] + bhi(U[j].w); }
    H2_LOAD(ua, 0)
    for (int sb = 0; sb < 128; sb += 16) {
        H2_LOAD(ub, sb + 8)
        H2_STEP(ua, sb)
        if (sb + 16 < 128) { H2_LOAD(ua, sb + 16) }
        H2_STEP(ub, sb + 8)
    }
#undef H2_LOAD
#undef H2_STEP
}
constexpr int PHP = 132;
constexpr int H3_PHF = 0, H3_PHB = 64 * PHP * 4, H3_QQ = 2 * 64 * PHP * 4, QP = 272, H3_VV = H3_QQ + 64 * QP, H3_AA = H3_VV + 64 * KP, AP = 144, H3_TOT = H3_AA + 64 * AP, H3_QI = H3_TOT + 4096, H3_END = H3_QI + 2 * 64 * QP;
constexpr int H3_ON = 0;
static_assert(H3_END <= MIX_LDS_BYTES, "H3 LDS map");
struct H3Pre { v4u lf[4]; v4u qv[4]; };
__device__ __forceinline__ void h3_lf_load(int u, int tid, const bf16* LFf, const bf16* LFb, const bf16* Qh, const bf16* Vh, H3Pre& P) {
    const int h = u & 7, c = u >> 3, t0 = c * 64;
#pragma unroll
    for (int i = 0; i < 2; ++i) { const int idx = tid + 512 * i, row = idx >> 4, c16 = idx & 15;
        P.lf[i] = *(const v4u*)(LFf + (size_t)(t0 + row) * HW + h * HKD + 8 * c16); P.lf[2 + i] = *(const v4u*)(LFb + (size_t)(t0 + row) * HW + h * HKD + 8 * c16); }
#pragma unroll
    for (int i = 0; i < 2; ++i) { const int idx = tid + 512 * i, row = idx >> 4, c16 = idx & 15;
        P.qv[i] = *(const v4u*)(Vh + (size_t)(t0 + row) * HW + h * HKD + 8 * c16); P.qv[2 + i] = *(const v4u*)(Qh + (size_t)(t0 + row) * HW + h * HKD + 8 * c16); }
}
__device__ __forceinline__ void h3_unit(int u, LAS char* L, int tid, const bf16* Qh, const bf16* Kf, const bf16* Kb, const bf16* LFf, const bf16* LFb, const bf16* Vh, const bf16* Gs,
                                        const bf16* SU, const float* nw, bf16* OA, int un, H3Pre& P) {
    const int h = u & 7, c = u >> 3, t0 = c * 64, lane = tid & 63, w = __builtin_amdgcn_readfirstlane(tid >> 6), k = lane + 64 * (w & 1), tq = w >> 1;
    const int hi = lane >> 5, r32 = lane & 31, q4 = (lane & 15) >> 2, p4 = lane & 3, g1 = (lane >> 4) & 1, tt = w & 1, vt = w >> 1;
    const int r16 = lane & 15, kq = lane >> 4;
    LAS float* TOT = (LAS float*)(L + H3_TOT); LAS float* PHF = (LAS float*)(L + H3_PHF); LAS float* PHB = (LAS float*)(L + H3_PHB);
#pragma unroll
    for (int i = 0; i < 2; ++i) { const int idx = tid + 512 * i, row = idx >> 4, c16 = idx & 15;
        *(LAS v4u*)(L + H3_VV + row * KP + c16 * 16) = P.qv[i]; *(LAS v4u*)(L + H3_QQ + row * QP + c16 * 16) = P.qv[2 + i]; }
#pragma unroll
    for (int i = 0; i < 2; ++i) { const int idx = tid + 512 * i, row = idx >> 4, c16 = idx & 15; const v4u a = P.lf[i], b = P.lf[2 + i];
        *(LAS f32x4*)(PHF + row * PHP + 8 * c16) = (f32x4){blo(a.x), bhi(a.x), blo(a.y), bhi(a.y)}; *(LAS f32x4*)(PHF + row * PHP + 8 * c16 + 4) = (f32x4){blo(a.z), bhi(a.z), blo(a.w), bhi(a.w)};
        *(LAS f32x4*)(PHB + row * PHP + 8 * c16) = (f32x4){blo(b.x), bhi(b.x), blo(b.y), bhi(b.y)}; *(LAS f32x4*)(PHB + row * PHP + 8 * c16 + 4) = (f32x4){blo(b.z), bhi(b.z), blo(b.w), bhi(b.w)}; }
    const int jd = w & 3, dd0 = w >> 2;
    __syncthreads();
    float pf[16], pb[16];
    { float sa = 0.f, sb = 0.f;
#pragma unroll
      for (int i = 0; i < 16; ++i) { sa += PHF[(16 * tq + i) * PHP + k]; pf[i] = sa; sb += PHB[(16 * tq + i) * PHP + k]; pb[i] = sb; } }
    TOT[(0 * 4 + tq) * 128 + k] = pf[15]; TOT[(1 * 4 + tq) * 128 + k] = pb[15];
    LAS unsigned* FL = (LAS unsigned*)(L + MISC_OFF) + 24;
    { const bool okw = __all((pf[15] >= -25.0f) && (pb[15] >= -25.0f)); if (lane == 0) FL[w] = okw ? 1u : 0u; }
    __syncthreads();
    bool fast; { unsigned f8 = 1u;
#pragma unroll
      for (int i = 0; i < 8; ++i) f8 &= FL[i];
      fast = __builtin_amdgcn_readfirstlane((int)f8) != 0; }
    LAS char* KI = L + H3_PHF;
    if (fast) { float preF = 0.f, sufB = 0.f;
#pragma unroll
      for (int q = 0; q < 4; ++q) { const float tf = TOT[(0 * 4 + q) * 128 + k], tb = TOT[(1 * 4 + q) * 128 + k]; if (q < tq) preF += tf; if (q > tq) sufB += tb; }
#pragma unroll
      for (int i = 0; i < 16; ++i) { const int t = 16 * tq + i; const float phf = preF + pf[i], phb = sufB + (pb[15] - (i ? pb[i - 1] : 0.f));
          const float lff = pf[i] - (i ? pf[i - 1] : 0.f), lfb = pb[i] - (i ? pb[i - 1] : 0.f);
          const float qv = bf2f(*(const LAS bf16*)(L + H3_QQ + t * QP + k * 2));
          *(LAS bf16*)(L + H3_QI + t * QP + k * 2) = (bf16)f2bf(qv * ex2(phf)); *(LAS bf16*)(L + H3_QI + 64 * QP + t * QP + k * 2) = (bf16)f2bf(qv * ex2(phb));
          *(LAS bf16*)(KI + t * QP + k * 2) = (bf16)f2bf((1.0f - ex2(lff)) * ex2(-phf)); *(LAS bf16*)(KI + 64 * QP + t * QP + k * 2) = (bf16)f2bf((1.0f - ex2(lfb)) * ex2(-phb)); } }
    else
    { float preF = 0.f, sufB = 0.f;
#pragma unroll
      for (int q = 0; q < 4; ++q) { const float tf = TOT[(0 * 4 + q) * 128 + k], tb = TOT[(1 * 4 + q) * 128 + k]; if (q < tq) preF += tf; if (q > tq) sufB += tb; }
#pragma unroll
      for (int i = 0; i < 16; ++i) { const int t = 16 * tq + i; const float phf = preF + pf[i], phb = sufB + (pb[15] - (i ? pb[i - 1] : 0.f));
          PHF[t * PHP + k] = phf; PHB[t * PHP + k] = phb;
          const float qv = bf2f(*(const LAS bf16*)(L + H3_QQ + t * QP + k * 2));
          *(LAS bf16*)(L + H3_QI + t * QP + k * 2) = (bf16)f2bf(qv * ex2(phf)); *(LAS bf16*)(L + H3_QI + 64 * QP + t * QP + k * 2) = (bf16)f2bf(qv * ex2(phb)); } }
    __syncthreads();
    h3_lf_load(un, tid, LFf, LFb, Qh, Vh, P);
    bf16x8 sfr[4][2];
    if (fast) {
#pragma unroll
        for (int kt2 = 0; kt2 < 4; ++kt2) { const bf16* sp = SU + st_tile(0, h, c, kt2 * 4 + vt) + lane * 16; sfr[kt2][0] = *(const bf16x8*)sp; sfr[kt2][1] = *(const bf16x8*)(sp + 8); }
        if (w < 4) { const int ti = (w == 0 || w == 3) ? 0 : 1, sj = (w == 0 || w == 2) ? 0 : 1;
            f32x16 af = {0.f, 0.f, 0.f, 0.f, 0.f, 0.f, 0.f, 0.f, 0.f, 0.f, 0.f, 0.f, 0.f, 0.f, 0.f, 0.f}, ab = af;
            if (w != 3) {
#pragma unroll
                for (int ks = 0; ks < 8; ++ks) af = __builtin_amdgcn_mfma_f32_32x32x16_bf16(*(const LAS bf16x8*)(KI + (32 * sj + r32) * QP + (16 * ks + 8 * hi) * 2), *(const LAS bf16x8*)(L + H3_QI + (32 * ti + r32) * QP + (16 * ks + 8 * hi) * 2), af, 0, 0, 0); }
            if (w != 2) {
#pragma unroll
                for (int ks = 0; ks < 8; ++ks) ab = __builtin_amdgcn_mfma_f32_32x32x16_bf16(*(const LAS bf16x8*)(KI + 64 * QP + (32 * sj + r32) * QP + (16 * ks + 8 * hi) * 2), *(const LAS bf16x8*)(L + H3_QI + 64 * QP + (32 * ti + r32) * QP + (16 * ks + 8 * hi) * 2), ab, 0, 0, 0); }
            const int tl = r32;
#pragma unroll
            for (int rq = 0; rq < 4; ++rq) { float o4[4];
#pragma unroll
                for (int j = 0; j < 4; ++j) { const int r = 4 * rq + j, sl = crow(r, hi);
                    o4[j] = (w < 2) ? ((sl <= tl ? af[r] : 0.f) + (sl >= tl ? ab[r] : 0.f)) : (w == 2 ? af[r] : ab[r]); }
                u32x2 o2; o2.x = cvtpk(o4[0], o4[1]); o2.y = cvtpk(o4[2], o4[3]);
                *(LAS u32x2*)(L + H3_AA + (32 * ti + tl) * AP + (32 * sj + 8 * rq + 4 * hi) * 2) = o2; }
        }
    } else {
    v4u ka[4], kb2[4];
#pragma unroll
    for (int i = 0; i < 4; ++i) { ka[i] = keys_of(*(const v4u*)((dd0 ? LFb : LFf) + (size_t)(t0 + 16 * jd + r16) * HW + h * HKD + 32 * i + 8 * kq)); kb2[i] = keys_of(*(const v4u*)((dd0 ? LFf : LFb) + (size_t)(t0 + 16 * jd + r16) * HW + h * HKD + 32 * i + 8 * kq)); }
    {
    { const int dd = dd0, s = 16 * jd + r16; const LAS float* PH = dd ? PHB : PHF;
      float ps[32];
#pragma unroll
      for (int i = 0; i < 4; ++i) { const f32x4 x = *(const LAS f32x4*)(PH + s * PHP + 32 * i + 8 * kq), y = *(const LAS f32x4*)(PH + s * PHP + 32 * i + 8 * kq + 4);
          ps[8 * i] = x[0]; ps[8 * i + 1] = x[1]; ps[8 * i + 2] = x[2]; ps[8 * i + 3] = x[3]; ps[8 * i + 4] = y[0]; ps[8 * i + 5] = y[1]; ps[8 * i + 6] = y[2]; ps[8 * i + 7] = y[3]; }
#define H3_KK(i, j) (((j) & 1) ? bhi(ka[i][(j) >> 1]) : blo(ka[i][(j) >> 1]))
      const int R0 = dd ? 16 * jd + 15 : 16 * jd;
      bool small = true;
#pragma unroll
      for (int i = 0; i < 4; ++i) { const f32x4 x = *(const LAS f32x4*)(PH + R0 * PHP + 32 * i + 8 * kq), y = *(const LAS f32x4*)(PH + R0 * PHP + 32 * i + 8 * kq + 4);
          const float r0v[8] = {x[0], x[1], x[2], x[3], y[0], y[1], y[2], y[3]};
#pragma unroll
          for (int j = 0; j < 8; ++j) small = small && (__builtin_fabsf(r0v[j] - ps[8 * i + j]) <= 100.0f); }
      if (__all(small)) {
          f32x4 d4 = {0.f, 0.f, 0.f, 0.f};
#pragma unroll
          for (int i = 0; i < 4; ++i) {
              const int t = 16 * jd + r16;
              const f32x4 x = *(const LAS f32x4*)(PH + t * PHP + 32 * i + 8 * kq), y = *(const LAS f32x4*)(PH + t * PHP + 32 * i + 8 * kq + 4);
              const f32x4 rx = *(const LAS f32x4*)(PH + R0 * PHP + 32 * i + 8 * kq), ry = *(const LAS f32x4*)(PH + R0 * PHP + 32 * i + 8 * kq + 4);
              const v4u qv = *(const LAS v4u*)(L + H3_QQ + t * QP + (32 * i + 8 * kq) * 2);
              const float pr0[8] = {rx[0], rx[1], rx[2], rx[3], ry[0], ry[1], ry[2], ry[3]};
              const float av[8] = {blo(qv.x) * ex2(x[0] - pr0[0]), bhi(qv.x) * ex2(x[1] - pr0[1]), blo(qv.y) * ex2(x[2] - pr0[2]), bhi(qv.y) * ex2(x[3] - pr0[3]),
                                   blo(qv.z) * ex2(y[0] - pr0[4]), bhi(qv.z) * ex2(y[1] - pr0[5]), blo(qv.w) * ex2(y[2] - pr0[6]), bhi(qv.w) * ex2(y[3] - pr0[7])};
              float bv[8];
#pragma unroll
              for (int j = 0; j < 8; ++j) bv[j] = H3_KK(i, j) * ex2(pr0[j] - ps[8 * i + j]);
              d4 = __builtin_amdgcn_mfma_f32_16x16x32_bf16(pack8f(av), pack8f(bv), d4, 0, 0, 0);
          }
#pragma unroll
          for (int r = 0; r < 4; ++r) { const int t = 16 * jd + 4 * kq + r;
              if (dd == 0 ? (s <= t) : (s > t)) *(LAS bf16*)(L + H3_AA + t * AP + s * 2) = (bf16)f2bf(d4[r]); }
      } else
      for (int tl = 0; tl < 16; ++tl) {
          const int t = 16 * jd + tl;
          f32x4 d4 = {0.f, 0.f, 0.f, 0.f};
#pragma unroll
          for (int i = 0; i < 4; ++i) {
              const f32x4 x = *(const LAS f32x4*)(PH + t * PHP + 32 * i + 8 * kq), y = *(const LAS f32x4*)(PH + t * PHP + 32 * i + 8 * kq + 4);
              const bf16x8 qr = *(const LAS bf16x8*)(L + H3_QQ + t * QP + (32 * i + 8 * kq) * 2);
              const float pt[8] = {x[0], x[1], x[2], x[3], y[0], y[1], y[2], y[3]};
              float wv[8];
#pragma unroll
              for (int j = 0; j < 8; ++j) wv[j] = H3_KK(i, j) * ex2(pt[j] - ps[8 * i + j]);
              d4 = __builtin_amdgcn_mfma_f32_16x16x32_bf16(pack8f(wv), qr, d4, 0, 0, 0);
          }
          if (r16 == 0) {
#pragma unroll
              for (int r = 0; r < 4; ++r) { const int sk = 16 * jd + 4 * kq + r; if (dd == 0 ? (sk <= t) : (sk > t)) *(LAS bf16*)(L + H3_AA + t * AP + sk * 2) = (bf16)f2bf(d4[r]); } }
      }
      if (dd == 0) {
          float e = 0.f;
#pragma unroll
          for (int i = 0; i < 4; ++i) { const v4u qv = *(const LAS v4u*)(L + H3_QQ + s * QP + (32 * i + 8 * kq) * 2);
              e += blo(qv.x) * blo(kb2[i].x) + bhi(qv.x) * bhi(kb2[i].x) + blo(qv.y) * blo(kb2[i].y) + bhi(qv.y) * bhi(kb2[i].y) + blo(qv.z) * blo(kb2[i].z) + bhi(qv.z) * bhi(kb2[i].z) + blo(qv.w) * blo(kb2[i].w) + bhi(qv.w) * bhi(kb2[i].w); }
          { int l2 = lane; asm volatile("" : "+v"(l2));
            e += __builtin_bit_cast(float, __builtin_amdgcn_ds_bpermute((l2 ^ 16) << 2, __builtin_bit_cast(int, e)));
            e += __builtin_bit_cast(float, __builtin_amdgcn_ds_bpermute((l2 ^ 32) << 2, __builtin_bit_cast(int, e))); }
          if (kq == 0) { LAS bf16* pd = (LAS bf16*)(L + H3_AA + s * AP + s * 2); *pd = (bf16)f2bf(bf2f(*pd) + e); }
      } }
#undef H3_KK
#pragma unroll
    for (int kt2 = 0; kt2 < 4; ++kt2) { const bf16* sp = SU + st_tile(0, h, c, kt2 * 4 + vt) + lane * 16; sfr[kt2][0] = *(const bf16x8*)sp; sfr[kt2][1] = *(const bf16x8*)(sp + 8); }
#pragma unroll
    for (int pass = 0; pass < 2; ++pass) { const int b = w + 8 * pass; if (b < 12) {
        const int dd = b >= 6, bb = dd ? b - 6 : b;
        const int jlo = bb < 3 ? 0 : (bb < 5 ? 1 : 2), ihi = bb < 3 ? bb + 1 : (bb < 5 ? bb - 1 : 3);
        const int i = dd ? jlo : ihi, j = dd ? ihi : jlo, R = dd ? 16 * j : 16 * j + 15;
        const LAS float* PH = dd ? PHB : PHF;
        f32x4 d4 = {0.f, 0.f, 0.f, 0.f};
#pragma unroll
        for (int st = 0; st < 4; ++st) {
            const int ko = 32 * st + 8 * kq;
            const f32x4 r0 = *(const LAS f32x4*)(PH + R * PHP + ko), r1 = *(const LAS f32x4*)(PH + R * PHP + ko + 4);
            const f32x4 a0 = *(const LAS f32x4*)(PH + (16 * i + r16) * PHP + ko), a1 = *(const LAS f32x4*)(PH + (16 * i + r16) * PHP + ko + 4);
            const f32x4 b0 = *(const LAS f32x4*)(PH + (16 * j + r16) * PHP + ko), b1 = *(const LAS f32x4*)(PH + (16 * j + r16) * PHP + ko + 4);
            const v4u qv = *(const LAS v4u*)(L + H3_QQ + (16 * i + r16) * QP + ko * 2);
            const v4u kv = keys_of(*(const v4u*)((dd ? LFb : LFf) + (size_t)(t0 + 16 * j + r16) * HW + h * HKD + ko));
            const float av[8] = {blo(qv.x) * ex2(a0[0] - r0[0]), bhi(qv.x) * ex2(a0[1] - r0[1]), blo(qv.y) * ex2(a0[2] - r0[2]), bhi(qv.y) * ex2(a0[3] - r0[3]),
                                 blo(qv.z) * ex2(a1[0] - r1[0]), bhi(qv.z) * ex2(a1[1] - r1[1]), blo(qv.w) * ex2(a1[2] - r1[2]), bhi(qv.w) * ex2(a1[3] - r1[3])};
            const float bv[8] = {blo(kv.x) * ex2(r0[0] - b0[0]), bhi(kv.x) * ex2(r0[1] - b0[1]), blo(kv.y) * ex2(r0[2] - b0[2]), bhi(kv.y) * ex2(r0[3] - b0[3]),
                                 blo(kv.z) * ex2(r1[0] - b1[0]), bhi(kv.z) * ex2(r1[1] - b1[1]), blo(kv.w) * ex2(r1[2] - b1[2]), bhi(kv.w) * ex2(r1[3] - b1[3])};
            d4 = __builtin_amdgcn_mfma_f32_16x16x32_bf16(pack8f(av), pack8f(bv), d4, 0, 0, 0);
        }
#pragma unroll
        for (int r = 0; r < 4; ++r) *(LAS bf16*)(L + H3_AA + (16 * i + 4 * kq + r) * AP + (16 * j + r16) * 2) = (bf16)f2bf(d4[r]);
    } } }
    }
    __syncthreads();
    const int tn = tid >> 3, part = tid & 7;
    const v4u g0 = *(const v4u*)(Gs + (size_t)(t0 + tn) * HW + h * HKD + 16 * part), g1v = *(const v4u*)(Gs + (size_t)(t0 + tn) * HW + h * HKD + 16 * part + 8);
    f32x4 nwv[4];
#pragma unroll
    for (int i = 0; i < 4; ++i) nwv[i] = *(const f32x4*)(nw + h * HKD + 16 * part + 4 * i);
    f32x16 acc = {0.f, 0.f, 0.f, 0.f, 0.f, 0.f, 0.f, 0.f, 0.f, 0.f, 0.f, 0.f, 0.f, 0.f, 0.f, 0.f};
    { lcp bb = (lcp)L + H3_VV + (8 * hi + q4) * KP + (32 * vt + 16 * g1 + 4 * p4) * 2; lcp aa = (lcp)L + H3_AA + (32 * tt + r32) * AP + (8 * hi) * 2;
#pragma unroll
      for (int ks = 0; ks < 4; ++ks) {
          const bf16x8 af2 = *(const LAS bf16x8*)(aa + 32 * ks);
          const bf16x8 bf = cat8(vtr(bb + 16 * ks * KP), vtr(bb + (16 * ks + 4) * KP));
          acc = __builtin_amdgcn_mfma_f32_32x32x16_bf16(af2, bf, acc, 0, 0, 0);
      } }
    bf16x8 sfb[4][2];
#pragma unroll
    for (int kt2 = 0; kt2 < 4; ++kt2) { const bf16* sp = SU + st_tile(1, h, c, kt2 * 4 + vt) + lane * 16; sfb[kt2][0] = *(const bf16x8*)sp; sfb[kt2][1] = *(const bf16x8*)(sp + 8); }
#pragma unroll
    for (int d = 0; d < 2; ++d)
#pragma unroll
        for (int kt2 = 0; kt2 < 4; ++kt2)
#pragma unroll
            for (int s2 = 0; s2 < 2; ++s2) {
                lcp qp = (lcp)L + H3_QI + d * 64 * QP + (32 * tt + r32) * QP + (32 * kt2 + 16 * s2 + 4 * hi) * 2;
                const u32x2 lo = *(const LAS u32x2*)qp, hh = *(const LAS u32x2*)(qp + 16);
                const v4u av = {lo.x, lo.y, hh.x, hh.y};
                acc = __builtin_amdgcn_mfma_f32_32x32x16_bf16(__builtin_bit_cast(bf16x8, av), d ? sfb[kt2][s2] : sfr[kt2][s2], acc, 0, 0, 0);
            }
    LAS float* ON = (LAS float*)(L + H3_ON);
#pragma unroll
    for (int r = 0; r < 16; ++r) ON[(32 * tt + crow(r, hi)) * PHP + 32 * vt + r32] = acc[r];
    __syncthreads();
    { const int t = tn; float ov[16]; float ss = 0.f;
#pragma unroll
      for (int i = 0; i < 4; ++i) { const f32x4 a = *(const LAS f32x4*)(ON + t * PHP + 16 * part + 4 * i); ov[4 * i] = a[0]; ov[4 * i + 1] = a[1]; ov[4 * i + 2] = a[2]; ov[4 * i + 3] = a[3];
          ss += (a[0] * a[0] + a[1] * a[1]) + (a[2] * a[2] + a[3] * a[3]); }
      ss += __shfl_xor(ss, 1); ss += __shfl_xor(ss, 2); ss += __shfl_xor(ss, 4);
      const float rs = 1.0f / sqrtf(ss * (1.0f / HKD) + 1e-6f);
      const float gg[16] = {blo(g0.x), bhi(g0.x), blo(g0.y), bhi(g0.y), blo(g0.z), bhi(g0.z), blo(g0.w), bhi(g0.w), blo(g1v.x), bhi(g1v.x), blo(g1v.y), bhi(g1v.y), blo(g1v.z), bhi(g1v.z), blo(g1v.w), bhi(g1v.w)};
      float ov2[16];
#pragma unroll
      for (int i = 0; i < 16; ++i) ov2[i] = ov[i] * rs * nwv[i >> 2][i & 3] * gg[i];
      bf16* op = OA + (size_t)(t0 + t) * OAW + h * HKD + 16 * part;
      *(bf16x8*)op = pack8f(ov2); *(bf16x8*)(op + 8) = pack8f(ov2 + 8); }
    __syncthreads();
}
}

struct Args { const float* in[14]; float* out; unsigned char* ws; int ph_lo, ph_hi; unsigned char bucket[400]; };
static_assert(sizeof(Args) == 14 * 8 + 8 + 8 + 8 + 400, "Args has no holes");
enum { IN_X = 0, IN_WIN, IN_LBF, IN_LBB, IN_HNW, IN_RBT, IN_WBH, IN_WBA, IN_WOUT, IN_NMIX, IN_NMLP, IN_WUP, IN_WDOWN, IN_FNW };
constexpr int PH_PRO = 0, PH_PER_LAYER = 8, PH_G1 = 0, PH_H1 = 1, PH_H2 = 2, PH_H3 = 3, PH_GAB = 4, PH_GO = 5, PH_GU = 6, PH_GD = 7, PH_FIN = 1 + DEPTH * PH_PER_LAYER, PH_TOTAL = PH_FIN + 1;

struct P0Tile { const float* src; bf16* dst; const float* ks; int N, K; };
constexpr int I_W1 = (DM / 64) * (NIN / 256), I_WU = (DM / 64) * (DFF / 256), I_WD = (DFF / 64) * (DM / 256), I_WO = (DM / 64) * (DM / 256), I_WA = (HW / 64) * (DM / 256), I_WB = (AOW / 64) * (DM / 256);
constexpr int I_LAYER = I_W1 + I_WU + I_WD + I_WO + I_WA + I_WB;
__device__ __forceinline__ P0Tile p0_decode(const Args& args, unsigned char* ws, int it, int wave, int lane) {
    const int l = it / I_LAYER; int r = it % I_LAYER; unsigned char* wl = ws + WS_W + (size_t)l * WL_STRIDE;
    const float* W; bf16* WT; const float* ks = nullptr; int K, N; const bool isw1 = r < I_W1;
    if (r < I_W1) { W = args.in[IN_WIN] + (size_t)l * DM * NIN; K = DM; N = NIN; WT = (bf16*)(wl + WL_W1); ks = args.in[IN_NMIX] + l * DM; }
    else if ((r -= I_W1) < I_WU) { W = args.in[IN_WUP] + (size_t)l * DM * DFF; K = DM; N = DFF; WT = (bf16*)(wl + WL_WU); ks = args.in[IN_NMLP] + l * DM; }
    else if ((r -= I_WU) < I_WD) { W = args.in[IN_WDOWN] + (size_t)l * DFF * DM; K = DFF; N = DM; WT = (bf16*)(wl + WL_WD); }
    else if ((r -= I_WD) < I_WO) { W = args.in[IN_WOUT] + (size_t)l * DM * DM; K = DM; N = DM; WT = (bf16*)(wl + WL_WO); }
    else if ((r -= I_WO) < I_WA) { W = args.in[IN_WBH] + (size_t)l * HW * DM; K = OAW; N = DM; WT = (bf16*)(wl + WL_WA); }
    else { r -= I_WA; W = args.in[IN_WBA] + (size_t)l * AOW * DM; K = OAW; N = DM; WT = (bf16*)(wl + WL_WA) + HW; }
    const int ntn = N >> 8, kb = r / ntn, nb = r - kb * ntn;
    int rowb = 256 * nb;
    if (isw1 && nb >= 38) { const int isb = nb >= 46 ? 1 : 0, b = nb - (isb ? 46 : 38); rowb = 9728 + 512 * b + 128 * isb + (wave >= 4 ? 128 : 0); }
    P0Tile t; t.src = W + (size_t)(64 * kb + 8 * wave) * N + 256 * nb + 4 * lane; t.dst = WT + (size_t)(rowb + 32 * wave + (lane >> 3)) * K + 64 * kb + 8 * (lane & 7);
    t.ks = ks ? ks + 64 * kb + 8 * wave : nullptr; t.N = N; t.K = K; return t;
}
__device__ __forceinline__ void p0_load(const P0Tile& t, f32x4 (&r)[8]) {
#pragma unroll
    for (int j = 0; j < 8; ++j) r[j] = *(const GAS f32x4*)(t.src + (size_t)j * t.N);
}
__device__ __forceinline__ void p0_to_lds(const P0Tile& t, f32x4 (&r)[8], LAS unsigned char* img, int wave, int lane) {
    if (t.ks) {
#pragma unroll
        for (int j = 0; j < 8; ++j) r[j] = r[j] * t.ks[j]; }
#pragma unroll
    for (int i = 0; i < 4; ++i) { v4u o; o.x = mix::cvtpk(r[0][i], r[1][i]); o.y = mix::cvtpk(r[2][i], r[3][i]); o.z = mix::cvtpk(r[4][i], r[5][i]); o.w = mix::cvtpk(r[6][i], r[7][i]);
        *(LAS v4u*)(img + (4 * lane + i) * 128 + 16 * (wave ^ (lane & 7))) = o; }
}
__device__ __forceinline__ void p0_from_lds(const P0Tile& t, LAS const unsigned char* img, int wave, int lane) {
#pragma unroll
    for (int j = 0; j < 4; ++j) { const int n = 32 * wave + 8 * j + (lane >> 3), ch = lane & 7;
        const v4u o = *(const LAS v4u*)(img + n * 128 + 16 * (ch ^ ((n >> 2) & 7)));
        *(GAS v4u*)(t.dst + (size_t)(8 * j) * t.K) = o; }
}

template <class Map>
__device__ __forceinline__ void p0_run(const Args& args, unsigned char* ws, LAS unsigned char* ring, int wave, int lane, int first, int count, int stride, Map map) {
    f32x4 ra[8]; int q = first, par = 0;
    if (q < count) { P0Tile ta = p0_decode(args, ws, map(q), wave, lane); p0_load(ta, ra);
        for (;;) {
            LAS unsigned char* img = ring + par * 32768;
            p0_to_lds(ta, ra, img, wave, lane);
            const P0Tile tc = ta; const int q1 = q + stride;
            if (q1 < count) { ta = p0_decode(args, ws, map(q1), wave, lane); p0_load(ta, ra); }
            __syncthreads();
            p0_from_lds(tc, img, wave, lane);
            if (q1 >= count) break;
            q = q1; par ^= 1; } }
    __syncthreads();
}
constexpr int P0_ND = 1024;
__device__ __forceinline__ void p0_split(int G, int& nfull, int& nd) { const int nwg = (M / 256) * (NIN / 256), maxt = (nwg + G - 1) / G; nfull = nwg - (maxt - 1) * G; nd = (nfull < G && maxt > 1) ? P0_ND : 0; }

__global__ void __launch_bounds__(NWAVES * 64, 2) skel_fwd(Args args) {
    extern __shared__ __attribute__((aligned(16))) unsigned char lds[];
    LAS unsigned char* const L = (LAS unsigned char*)lds;
    volatile LAS unsigned* MISC = (volatile LAS unsigned*)(L + MISC_OFF);
    const int tid = threadIdx.x, lane = tid & 63, wave = __builtin_amdgcn_readfirstlane(tid >> 6);
    const int G = gridDim.x, bx = blockIdx.x;
    unsigned char* ws = args.ws;
    gu32* ctl = (gu32*)(ws + WS_CTL);
    float* SS = (float*)(ws + WS_SSP);
    for (int u = tid; u < (LDS_BYTES - LDSCTL_OFF) / 4; u += NWAVES * 64) ((LAS unsigned*)(L + LDSCTL_OFF))[u] = 0u;
    __syncthreads();
    XcdBarrier bar = xcd_barrier_post((unsigned*)(ctl + CW_BAR), MISC + 8);
    const int lo = args.ph_lo, hi = args.ph_hi;
#define IN(k) (lo <= (k) && (k) < hi)
#define BOTH(k) (IN(k) && IN((k) + 1))
#define GRID_BAR() xcd_barrier(bar, wave * 64 + lane_now())
    const int gw = bx * NWAVES + wave, NGW = G * NWAVES;

    if (IN(PH_PRO)) {
        { int nfull, nd; p0_split(G, nfull, nd); const int per = I_LAYER - nd;
          p0_run(args, ws, L + RING_OFF, wave, lane, bx, I_LAYER + (DEPTH - 1) * per, G, [=](int q) { if (q < I_LAYER) return q; const int q2 = q - I_LAYER, l = 1 + q2 / per; return l * I_LAYER + (q2 - (l - 1) * per); }); }
        { const float* x = args.in[IN_X]; bf16* XB = (bf16*)(ws + WS_XB);
          for (int m = gw; m < M; m += NGW) {
              const GAS f32x4* xr = (const GAS f32x4*)(x + (size_t)m * DM) + lane; float s = 0.f;
              GAS unsigned long long* o8 = (GAS unsigned long long*)(XB + (size_t)m * DM) + lane;
#pragma unroll
              for (int j = 0; j < 8; ++j) { const f32x4 v = xr[64 * j]; s += (v.x * v.x + v.y * v.y) + (v.z * v.z + v.w * v.w);
                  o8[64 * j] = (unsigned long long)pk2(v.x, v.y) | ((unsigned long long)pk2(v.z, v.w) << 32); }
              s = wave_sum(s); if (lane < 32) SS[(size_t)m * 32 + lane] = (lane == 0) ? s : 0.f; } }
        { float* LB = (float*)(ws + WS_LB);
          for (int i = bx * NWAVES * 64 + tid; i < 2 * HW; i += G * NWAVES * 64) { const int d = i / HW, c = i % HW; const float* lg = args.in[d ? IN_LBB : IN_LBF];
              const float a0 = lg[c], a1 = lg[HW + c], a2 = lg[2 * HW + c], a3 = lg[3 * HW + c]; const float mx = fmaxf(fmaxf(a0, a1), fmaxf(a2, a3));
              const float e0 = expf(a0 - mx), e1 = expf(a1 - mx), e2 = expf(a2 - mx), e3 = expf(a3 - mx), inv = 1.0f / (e0 + e1 + e2 + e3);
              const float p0 = e0 * inv, p1 = e1 * inv, p2 = e2 * inv, p3 = e3 * inv; const float c0 = p0, c1 = c0 + p1, c2 = c1 + p2, c3 = c2 + p3;
              LB[(0 * 2 + d) * HW + c] = c0 - p0; LB[(1 * 2 + d) * HW + c] = c1 - p0; LB[(2 * 2 + d) * HW + c] = c2 - p0; LB[(3 * 2 + d) * HW + c] = c3 - p0; } }
        { float* BI = (float*)(ws + WS_BIAS); const float* rbt = args.in[IN_RBT];
          for (int i = bx * NWAVES * 64 + tid; i < 12 * 192; i += G * NWAVES * 64) { const int hg = i / 192, j = i % 192 - 32, n = hg >> 2;
              BI[i] = (j >= 0 && j < 129) ? rbt[(int)args.bucket[n * 132 + j] * 12 + hg] * 1.4426950408889634f : -1e30f; } }
        if (BOTH(PH_PRO)) GRID_BAR();
    }

    for (int l = 0; l < DEPTH; ++l) {
        const int pb = 1 + l * PH_PER_LAYER;
        unsigned char* wl = ws + WS_W + (size_t)l * WL_STRIDE;
        bf16* XB = (bf16*)(ws + WS_XB);
        if (IN(pb + PH_G1)) {
            pg8::Gemm g{XB, (const bf16*)(wl + WL_W1), M, NIN, DM, DM, DM}; pg8::StaticOrder S; S.init(M, NIN, G, bx, 32);
            pg8::EpiG1 E{ws, SS + (size_t)(2 * l) * M * 32, (const float*)(ws + WS_LB) + l * 2 * HW};
            pg8::gemm_phase<pg8::EpiG1, pg8::StaticOrder, true, true>(L + RING_OFF, g, S, E, wave);
            if (l + 1 < DEPTH) { int nfull, nd; p0_split(G, nfull, nd);
                if (nd > 0 && bx >= nfull) { const int base = (l + 1) * I_LAYER + (I_LAYER - nd); p0_run(args, ws, L + RING_OFF, wave, lane_now(), bx - nfull, nd, G - nfull, [=](int q) { return base + q; }); } }
            if (BOTH(pb + PH_G1)) GRID_BAR();
        }
        if (IN(pb + PH_H1)) {
            const int t2 = wave * 64 + lane_now();
            if (bx < NHH * 128) { mix::H1Pre P; mix::h1_load(bx, t2, (const bf16*)(ws + WS_KF), (const bf16*)(ws + WS_KB), (const bf16*)(ws + WS_LFF), (const bf16*)(ws + WS_LFB), (const bf16*)(ws + WS_VH), P);
              for (int u = bx; u < NHH * 128; u += G)
                mix::h1_unit(u, (LAS char*)L, t2, (const bf16*)(ws + WS_KF), (const bf16*)(ws + WS_KB), (const bf16*)(ws + WS_LFF), (const bf16*)(ws + WS_LFB), (const bf16*)(ws + WS_VH), (bf16*)(ws + WS_SU), (float*)(ws + WS_DD),
                              (u + G < NHH * 128) ? u + G : u, P); }
            if (BOTH(pb + PH_H1)) GRID_BAR();
        }
        if (IN(pb + PH_H2)) {
            const int t2 = wave * 64 + lane_now();
            if (t2 == 0) MISC[16] = 0u;
            __syncthreads();
            if (wave < 2) { for (int gid = bx * 128 + t2; gid < 2 * NHH * 16 * 128; gid += G * 128) mix::h2_scan(gid, (bf16*)(ws + WS_SU), (const float*)(ws + WS_DD), (LAS float*)(L + mix::H2_DL + wave * mix::H2_DL_WAVE), t2 & 63); }
            for (;;) {
                const int ln = lane_now();
                unsigned j = 0; if (ln == 0) j = __hip_atomic_fetch_add((LAS unsigned*)(L + MISC_OFF) + 16, 1u, __ATOMIC_RELAXED, __HIP_MEMORY_SCOPE_WORKGROUP);
                j = (unsigned)__builtin_amdgcn_readfirstlane((int)j); const int per = (3 * 1024 + G - 1) / G; if ((int)j >= per) break;
                const int it = bx * per + (int)j; if (it >= 3 * 1024) break;
                mix::attn_item(it, ln, (LAS char*)L + wave * mix::ATT_WAVE_LDS, (const bf16*)(ws + WS_AQ), (const bf16*)(ws + WS_AK), (const bf16*)(ws + WS_AV), (const float*)(ws + WS_BIAS), (bf16*)(ws + WS_OP), (float*)(ws + WS_LSE)); }
            if (BOTH(pb + PH_H2)) GRID_BAR();
        }
        if (IN(pb + PH_H3)) {
            const int t2 = wave * 64 + lane_now();
            if (bx < NHH * 128) { mix::H3Pre P; mix::h3_lf_load(bx, t2, (const bf16*)(ws + WS_LFF), (const bf16*)(ws + WS_LFB), (const bf16*)(ws + WS_QH), (const bf16*)(ws + WS_VH), P);
              for (int u = bx; u < NHH * 128; u += G)
                mix::h3_unit(u, (LAS char*)L, t2, (const bf16*)(ws + WS_QH), (const bf16*)(ws + WS_KF), (const bf16*)(ws + WS_KB), (const bf16*)(ws + WS_LFF), (const bf16*)(ws + WS_LFB), (const bf16*)(ws + WS_VH),
                             (const bf16*)(ws + WS_GS), (const bf16*)(ws + WS_SU), args.in[IN_HNW] + l * HW, (bf16*)(ws + WS_OA), (u + G < NHH * 128) ? u + G : u, P); }
            mix::attn_combine(bx * NWAVES * 64 + wave * 64 + lane_now(), G * NWAVES * 64, (const bf16*)(ws + WS_OP), (const float*)(ws + WS_LSE), (bf16*)(ws + WS_OA));
            if (BOTH(pb + PH_H3)) GRID_BAR();
        }
        if (IN(pb + PH_GAB)) {
            bf16* OA = (bf16*)(ws + WS_OA);
            { pg8::Gemm g{OA, (const bf16*)(wl + WL_WA), M, DM, OAW, OAW, OAW}; pg8::StaticOrder S; S.init(M, DM, G, bx);
              pg8::EpiGAB E{ws};
              pg8::gemm_phase<pg8::EpiGAB, pg8::StaticOrder, true, true, HW / 64>(L + RING_OFF, g, S, E, wave); }
            if (BOTH(pb + PH_GAB)) GRID_BAR();
        }
        if (IN(pb + PH_GO)) {
            pg8::Gemm g{(const bf16*)(ws + WS_MG), (const bf16*)(wl + WL_WO), M, DM, DM, DM, DM}; pg8::StaticOrder S; S.init(M, DM, G, bx);
            pg8::EpiRes E{XB, SS + (size_t)(2 * l + 1) * M * 32, DM};
            pg8::gemm_phase<pg8::EpiRes, pg8::StaticOrder, true, true>(L + RING_OFF, g, S, E, wave);
            if (BOTH(pb + PH_GO)) GRID_BAR();
        }
        if (IN(pb + PH_GU)) {
            pg8::Gemm g{XB, (const bf16*)(wl + WL_WU), M, DFF, DM, DM, DM}; pg8::StaticOrder S; S.init(M, DFF, G, bx);
            pg8::EpiUp E{SS + (size_t)(2 * l + 1) * M * 32, (bf16*)(ws + WS_UU), DFF};
            pg8::gemm_phase<pg8::EpiUp, pg8::StaticOrder, true, true>(L + RING_OFF, g, S, E, wave);
            if (BOTH(pb + PH_GU)) GRID_BAR();
        }
        if (IN(pb + PH_GD)) {
            pg8::Gemm g{(const bf16*)(ws + WS_UU), (const bf16*)(wl + WL_WD), M, DM, DFF, DFF, DFF}; pg8::StaticOrder S; S.init(M, DM, G, bx);
            pg8::EpiRes E{XB, SS + (size_t)(2 * l + 2) * M * 32, DM};
            pg8::gemm_phase<pg8::EpiRes, pg8::StaticOrder, true, true>(L + RING_OFF, g, S, E, wave);
            if (BOTH(pb + PH_GD)) GRID_BAR();
        }
    }
    if (IN(PH_FIN)) {
        const int lane = (int)__builtin_amdgcn_mbcnt_hi(~0u, __builtin_amdgcn_mbcnt_lo(~0u, 0u));
        const bf16* XBf = (const bf16*)(ws + WS_XB); const float* fw = args.in[IN_FNW];
        for (int m = gw; m < M; m += NGW) {
            const GAS v4u* xr = (const GAS v4u*)(XBf + (size_t)m * DM) + lane; float v[32]; float s = 0.f;
#pragma unroll
            for (int j = 0; j < 4; ++j) { const v4u w = xr[64 * j]; v[8 * j] = mix::blo(w.x); v[8 * j + 1] = mix::bhi(w.x); v[8 * j + 2] = mix::blo(w.y); v[8 * j + 3] = mix::bhi(w.y);
                v[8 * j + 4] = mix::blo(w.z); v[8 * j + 5] = mix::bhi(w.z); v[8 * j + 6] = mix::blo(w.w); v[8 * j + 7] = mix::bhi(w.w); }
#pragma unroll
            for (int i = 0; i < 32; ++i) s += v[i] * v[i];
            const float rs = 1.0f / sqrtf(wave_sum(s) * (1.0f / DM) + pg8::RMS_EPS);
#pragma unroll
            for (int j = 0; j < 4; ++j) { const f32x4 w0 = *(const GAS f32x4*)(fw + 512 * j + 8 * lane), w1 = *(const GAS f32x4*)(fw + 512 * j + 8 * lane + 4);
                GAS f32x4* o = (GAS f32x4*)(args.out + (size_t)m * DM + 512 * j + 8 * lane);
                o[0] = (f32x4){v[8 * j] * rs * w0[0], v[8 * j + 1] * rs * w0[1], v[8 * j + 2] * rs * w0[2], v[8 * j + 3] * rs * w0[3]};
                o[1] = (f32x4){v[8 * j + 4] * rs * w1[0], v[8 * j + 5] * rs * w1[1], v[8 * j + 6] * rs * w1[2], v[8 * j + 7] * rs * w1[3]}; }
        }
    }
#undef IN
#undef BOTH
#undef GRID_BAR
}

static int t5_bucket_host(int rel) {
    const int half = 16, max_exact = 8; int ret = rel > 0 ? half : 0; const int n = rel < 0 ? -rel : rel;
    int large = max_exact + (int)(std::log((double)(n > 1 ? n : 1) / max_exact) / std::log(1024.0 / max_exact) * (half - max_exact));
    if (large > half - 1) large = half - 1;
    return ret + (n < max_exact ? n : large);
}
extern "C" void kernel_launch(void* const* d_in, const int* in_sizes, int n_in, void* d_out, int out_size, void* d_ws, size_t ws_size, hipStream_t stream) {
    static int grid = 0;
    if (grid == 0) {
        if (n_in != 14 || in_sizes[0] != M * DM || out_size != M * DM || ws_size < WS_END) { fprintf(stderr, "kernel_launch: unexpected shapes / workspace (%d inputs, ws %zu, need %zu)\n", n_in, ws_size, (size_t)WS_END); grid = -1; return; }
        int dev = 0, cus = 0;
        if (hipGetDevice(&dev) != hipSuccess || hipDeviceGetAttribute(&cus, hipDeviceAttributeMultiprocessorCount, dev) != hipSuccess) { grid = -1; return; }
        if (hipFuncSetAttribute((const void*)skel_fwd, hipFuncAttributeMaxDynamicSharedMemorySize, LDS_BYTES) != hipSuccess) { grid = -1; return; }
        int per_cu = 0; (void)hipOccupancyMaxActiveBlocksPerMultiprocessor(&per_cu, (const void*)skel_fwd, NWAVES * 64, LDS_BYTES); (void)hipGetLastError();
        grid = cus;
    }
    if (grid < 0) return;
    (void)hipMemsetAsync((char*)d_ws + WS_CTL, 0, CTL_ZERO_BYTES, stream);
    Args a; memset(&a, 0, sizeof(a));
    for (int i = 0; i < 14; ++i) a.in[i] = (const float*)d_in[i];
    a.out = (float*)d_out; a.ws = (unsigned char*)d_ws;
    { const int dils[3] = {1, 4, 16}; for (int n = 0; n < 3; ++n) for (int j = 0; j < 129; ++j) a.bucket[n * 132 + j] = (unsigned char)t5_bucket_host((j - 64) * dils[n]); }
    auto frame = [&](int lo, int hi) { a.ph_lo = lo; a.ph_hi = hi; hipLaunchKernelGGL(skel_fwd, dim3(grid), dim3(NWAVES * 64), LDS_BYTES, stream, a); };
#if defined(MK_LAUNCH_PER_PHASE)
    for (int ph = 0; ph < PH_TOTAL; ++ph) frame(ph, ph + 1);
#else
    frame(0, PH_TOTAL);
#endif
#if defined(PROBE_PHASE)
    for (int r = 0; r < PROBE_REPS; ++r) frame(1 + 3 * PH_PER_LAYER + PROBE_PHASE, 1 + 3 * PH_PER_LAYER + PROBE_PHASE + 1);
#endif
}
```
